# Optimizing an MI355X kernel written in HIP

```python
import jax, jax.numpy as jnp
from jax import lax
import numpy as np

D_MODEL = 2048
BATCH = 2
SEQ = 8192
DEPTH = 1

CHUNK = 64
D_MIX = D_MODEL

HG_WIDTH = D_MIX // 2
HG_EXPAND = 128
HG_HEADS = HG_WIDTH // HG_EXPAND
HG_DK = HG_EXPAND
HG_DV = HG_WIDTH // HG_HEADS

MLA_WIDTH = D_MIX - HG_WIDTH
V_DIM = 128
MLA_HEADS = MLA_WIDTH // V_DIM
QK_NOPE = 128
QK_ROPE = 64
QK_DIM = QK_NOPE + QK_ROPE
Q_LORA = 512
KV_LORA = 512
ROPE_THETA = 10000.0
Q_BLOCK = 128
ATTN_SCALE = QK_DIM ** -0.5

D_FF = ((8 * D_MODEL // 3 + 255) // 256) * 256

NORM_EPS = 1e-6

IN_SIZES = (HG_WIDTH, HG_WIDTH, HG_WIDTH, HG_WIDTH, Q_LORA, KV_LORA, QK_ROPE)
D_IN = sum(IN_SIZES)
IN_SPLITS = tuple(int(v) for v in np.cumsum(IN_SIZES)[:-1])

kernel_name = "hymba_style_hgrn2_mla_swiglu"


def rms_norm(x, w):
    xf = x.astype(jnp.float32)
    y = xf * lax.rsqrt(jnp.mean(xf * xf, axis=-1, keepdims=True) + NORM_EPS)
    return (y * w.astype(jnp.float32)).astype(x.dtype)


def rope_tables(positions):
    inv_freq = 1.0 / (ROPE_THETA ** (jnp.arange(0, QK_ROPE, 2, dtype=jnp.float32) / QK_ROPE))
    ang = positions.astype(jnp.float32)[..., None] * inv_freq
    return jnp.cos(ang)[:, :, None, :], jnp.sin(ang)[:, :, None, :]


def rope_tail(t, cos, sin):
    t_nope, t_rope = jnp.split(t, [QK_NOPE], axis=-1)
    r1, r2 = jnp.split(t_rope, 2, axis=-1)
    c = cos.astype(t.dtype)
    s = sin.astype(t.dtype)
    return jnp.concatenate([t_nope, r1 * c - r2 * s, r1 * s + r2 * c], axis=-1)


def hgrn2_mixer(q, f_pre, i, g, lb, norm_w):
    B_, S_, _ = q.shape
    n_chunks = S_ // CHUNK
    qf = jax.nn.silu(q.astype(jnp.float32))
    f = lb + (1.0 - lb) * jax.nn.sigmoid(f_pre.astype(jnp.float32))
    kf = 1.0 - f

    def chunked(t, d):
        return t.reshape(B_, n_chunks, CHUNK, HG_HEADS, d).transpose(1, 0, 3, 2, 4)

    qc = chunked(qf, HG_DK)
    kc = chunked(kf, HG_DK)
    vc = chunked(i.astype(jnp.float32), HG_DV)
    bc = jnp.cumsum(chunked(jnp.log(f), HG_DK), axis=3)
    causal = jnp.tril(jnp.ones((CHUNK, CHUNK), dtype=bool))[:, :, None]

    def step(state, inp):
        q_c, k_c, v_c, b_c = inp
        rel = b_c[:, :, :, None, :] - b_c[:, :, None, :, :]
        decay = jnp.exp(jnp.where(causal, rel, -jnp.inf))
        scores = jnp.einsum('bhtd,bhsd,bhtsd->bhts', q_c, k_c, decay)
        o = (jnp.einsum('bhts,bhsv->bhtv', scores, v_c)
             + jnp.einsum('bhtd,bhdv->bhtv', q_c * jnp.exp(b_c), state))
        b_last = b_c[:, :, -1:, :]
        state = (jnp.exp(b_last[:, :, 0, :, None]) * state
                 + jnp.einsum('bhsd,bhsv->bhdv', k_c * jnp.exp(b_last - b_c), v_c))
        return state, o

    state0 = jnp.zeros((B_, HG_HEADS, HG_DK, HG_DV), jnp.float32)
    _, o = lax.scan(step, state0, (qc, kc, vc, bc))
    o = o.transpose(1, 0, 3, 2, 4).reshape(B_, S_, HG_HEADS, HG_DV)
    gate = jax.nn.silu(g.astype(jnp.float32)).reshape(B_, S_, HG_HEADS, HG_DV)
    o = rms_norm(o, norm_w) * gate
    return o.reshape(B_, S_, HG_WIDTH).astype(g.dtype)


def mla_mixer(c_q, c_kv, k_rope, cos, sin, q_norm_w, w_uq, kv_norm_w, w_ukv, q_head_w, k_head_w):
    B_, S_, _ = c_q.shape
    q = (rms_norm(c_q, q_norm_w) @ w_uq).reshape(B_, S_, MLA_HEADS, QK_DIM)
    kv = (rms_norm(c_kv, kv_norm_w) @ w_ukv).reshape(B_, S_, MLA_HEADS, QK_NOPE + V_DIM)
    k_nope, v = jnp.split(kv, [QK_NOPE], axis=-1)
    k = jnp.concatenate(
        [k_nope, jnp.broadcast_to(k_rope[:, :, None, :], (B_, S_, MLA_HEADS, QK_ROPE))], axis=-1)
    q = rope_tail(rms_norm(q, q_head_w), cos, sin)
    k = rope_tail(rms_norm(k, k_head_w), cos, sin)

    n_blocks = S_ // Q_BLOCK
    q_blocks = q.reshape(B_, n_blocks, Q_BLOCK, MLA_HEADS, QK_DIM).transpose(1, 0, 2, 3, 4)
    key_chunk = jnp.arange(S_) // CHUNK

    def attend(args):
        q_blk, blk = args
        query_chunk = (blk * Q_BLOCK + jnp.arange(Q_BLOCK)) // CHUNK
        s = jnp.einsum('bqhd,bkhd->bhqk', q_blk, k).astype(jnp.float32) * ATTN_SCALE
        s = jnp.where(key_chunk[None, :] <= query_chunk[:, None], s, -jnp.inf)
        p = jax.nn.softmax(s, axis=-1).astype(v.dtype)
        return jnp.einsum('bhqk,bkhv->bqhv', p, v)

    o = lax.map(attend, (q_blocks, jnp.arange(n_blocks)))
    return o.transpose(1, 0, 2, 3, 4).reshape(B_, S_, MLA_WIDTH)


def setup_inputs(seed: int = 0) -> dict:
    key = jax.random.key(seed)
    ks = jax.random.split(key, 17)
    f32 = jnp.float32

    def nrm(k, shape, fan_in):
        return jax.random.normal(k, shape, f32) * (fan_in ** -0.5)

    def gain(k, shape):
        return 1.0 + 0.02 * jax.random.normal(k, shape, f32)

    x = jax.random.normal(ks[0], (BATCH, SEQ, D_MODEL), f32)
    offset = jax.random.randint(ks[1], (BATCH, 1), 0, 4096, dtype=jnp.int32)
    positions = offset + jnp.arange(SEQ, dtype=jnp.int32)[None, :]
    return {
        "x": x,
        "positions": positions,
        "attn_norm_w": gain(ks[2], (DEPTH, D_MODEL)),
        "w_in": nrm(ks[3], (DEPTH, D_MODEL, D_IN), D_MODEL),
        "hgrn_lb": 0.5 * jax.random.normal(ks[4], (DEPTH + 1, HG_HEADS * HG_DK), f32),
        "hgrn_norm_w": gain(ks[5], (DEPTH, HG_DV)),
        "mla_q_norm_w": gain(ks[6], (DEPTH, Q_LORA)),
        "w_uq": nrm(ks[7], (DEPTH, Q_LORA, MLA_HEADS * QK_DIM), Q_LORA),
        "mla_kv_norm_w": gain(ks[8], (DEPTH, KV_LORA)),
        "w_ukv": nrm(ks[9], (DEPTH, KV_LORA, MLA_HEADS * (QK_NOPE + V_DIM)), KV_LORA),
        "q_head_norm_w": gain(ks[10], (DEPTH, QK_DIM)),
        "k_head_norm_w": gain(ks[11], (DEPTH, QK_DIM)),
        "w_out": nrm(ks[12], (DEPTH, D_MIX, D_MODEL), D_MIX),
        "ffn_norm_w": gain(ks[13], (DEPTH, D_MODEL)),
        "w_gate_up": nrm(ks[14], (DEPTH, D_MODEL, 2 * D_FF), D_MODEL),
        "w_down": nrm(ks[15], (DEPTH, D_FF, D_MODEL), D_FF),
    }


def reference(x, positions, attn_norm_w, w_in, hgrn_lb, hgrn_norm_w, mla_q_norm_w, w_uq,
              mla_kv_norm_w, w_ukv, q_head_norm_w, k_head_norm_w, w_out, ffn_norm_w,
              w_gate_up, w_down):
    cos, sin = rope_tables(positions)
    lower_bounds = jnp.cumsum(jax.nn.softmax(hgrn_lb.astype(jnp.float32), axis=0), axis=0)
    for layer in range(DEPTH):
        h = rms_norm(x, attn_norm_w[layer])
        proj = h @ w_in[layer]
        hq, hf, hi, hg, c_q, c_kv, k_r = jnp.split(proj, IN_SPLITS, axis=-1)
        o_a = hgrn2_mixer(hq, hf, hi, hg, lower_bounds[layer], hgrn_norm_w[layer])
        o_b = mla_mixer(c_q, c_kv, k_r, cos, sin, mla_q_norm_w[layer], w_uq[layer],
                        mla_kv_norm_w[layer], w_ukv[layer], q_head_norm_w[layer],
                        k_head_norm_w[layer])
        x = x + jnp.concatenate([o_a, o_b], axis=-1) @ w_out[layer]
        h = rms_norm(x, ffn_norm_w[layer])
        gate, up = jnp.split(h @ w_gate_up[layer], 2, axis=-1)
        x = x + (jax.nn.silu(gate) * up) @ w_down[layer]
    return x
```

```cpp
#include <hip/hip_runtime.h>
#include <hip/hip_cooperative_groups.h>
#include <cstdio>
#include <cstdint>
namespace cg = cooperative_groups;

#define LAS __attribute__((address_space(3)))
typedef unsigned short bf16_t;
typedef short bf16x8 __attribute__((ext_vector_type(8)));
typedef float f32x4 __attribute__((ext_vector_type(4)));
typedef float f32x16 __attribute__((ext_vector_type(16)));
typedef unsigned u32x4 __attribute__((ext_vector_type(4)));
typedef unsigned u32x2 __attribute__((ext_vector_type(2)));
typedef float f32x2_t __attribute__((ext_vector_type(2)));
typedef __bf16 bf16x2_t __attribute__((ext_vector_type(2)));

constexpr int DM = 2048, BATCH = 2, SEQ = 8192, T = BATCH * SEQ;
constexpr int CHUNK = 64, NCH = SEQ / CHUNK;
constexpr int HGW = 1024, HGH = 8, HDK = 128, HDV = 128;
constexpr int MH = 8, VD = 128, NOPE = 128, ROPE = 64, QKD = 192, QL = 512, KVL = 512;
constexpr int DFF = 5632;
constexpr int DIN = 5184, DINP = 5376;
constexpr float EPS = 1e-6f;
constexpr float LOG2E = 1.4426950408889634f;
constexpr float QSCALE = 0.07216878364870323f * LOG2E;

constexpr size_t MiB = 1u << 20;
constexpr size_t WS_WIN = 0, WS_WGU = 21 * MiB, WS_WDN = 65 * MiB, WS_WOUT = 87 * MiB, WS_WUQ = 95 * MiB, WS_WUKV = 97 * MiB;
constexpr size_t WS_XB = 100 * MiB;
constexpr size_t WS_PROJ = 164 * MiB;
constexpr size_t WS_KN = 340 * MiB;
constexpr size_t WS_VT = 388 * MiB;
constexpr size_t WS_MIX = 420 * MiB;
constexpr size_t WS_ROPE = 484 * MiB;
constexpr size_t WS_DEC = 488 * MiB;
constexpr size_t WS_RS1 = 489 * MiB;
constexpr size_t WS_SS2 = 489 * MiB + 65536;
constexpr size_t WS_EMID = 490 * MiB;
constexpr size_t WS_LB = 491 * MiB;
constexpr size_t WS_BAR = 491 * MiB + 65536;
constexpr size_t WS_END = 492 * MiB;
constexpr size_t OUT_ST = 0, OUT_Q = 64 * MiB;

constexpr int LDS_BYTES = 147456;

struct Params {
    const float* x; const int* pos; const float* attn_norm_w; const float* w_in; const float* hgrn_lb; const float* hgrn_norm_w;
    const float* q_norm_w; const float* w_uq; const float* kv_norm_w; const float* w_ukv; const float* qh_w; const float* kh_w;
    const float* w_out; const float* ffn_norm_w; const float* w_gu; const float* w_dn;
    float* out; unsigned char* ws;
};

__device__ __forceinline__ int opaque_tid() { int t = threadIdx.x; asm volatile("" : "+v"(t)); return t; }
__device__ __forceinline__ unsigned cvtpk(float lo, float hi) { f32x2_t v = {lo, hi}; bf16x2_t b = __builtin_convertvector(v, bf16x2_t); return __builtin_bit_cast(unsigned, b); }
__device__ __forceinline__ float bflo(unsigned u) { return __uint_as_float(u << 16); }
__device__ __forceinline__ float bfhi(unsigned u) { return __uint_as_float(u & 0xffff0000u); }
__device__ __forceinline__ float bf1(unsigned short u) { return __uint_as_float((unsigned)u << 16); }
__device__ __forceinline__ float wave_sum(float v) {
#pragma unroll
    for (int o = 1; o < 64; o <<= 1) v += __shfl_xor(v, o);
    return v;
}
__device__ __forceinline__ float wave_max(float v) {
#pragma unroll
    for (int o = 1; o < 64; o <<= 1) v = fmaxf(v, __shfl_xor(v, o));
    return v;
}
__device__ __forceinline__ float siluf(float x) { return x * __builtin_amdgcn_rcpf(1.f + __expf(-x)); }
__device__ __forceinline__ float sigmoidf_(float x) { return __builtin_amdgcn_rcpf(1.f + __expf(-x)); }
__device__ __forceinline__ int crow(int reg, int h) { return (reg & 3) + 8 * (reg >> 2) + 4 * h; }
__device__ __forceinline__ int pi32(int r) { return (r & ~12) | ((r & 4) << 1) | ((r & 8) >> 1); }
#define MFMA32(a, b, c) __builtin_amdgcn_mfma_f32_32x32x16_bf16((a), (b), (c), 0, 0, 0)
__device__ __forceinline__ bf16x8 pack8(const f32x16& x, int s) {
    u32x4 p;
    p.x = cvtpk(x[8 * s + 0], x[8 * s + 1]); p.y = cvtpk(x[8 * s + 2], x[8 * s + 3]);
    p.z = cvtpk(x[8 * s + 4], x[8 * s + 5]); p.w = cvtpk(x[8 * s + 6], x[8 * s + 7]);
    return __builtin_bit_cast(bf16x8, p);
}
__device__ __forceinline__ void unpack8(u32x4 w, float* f) {
    f[0] = bflo(w.x); f[1] = bfhi(w.x); f[2] = bflo(w.y); f[3] = bfhi(w.y); f[4] = bflo(w.z); f[5] = bfhi(w.z); f[6] = bflo(w.w); f[7] = bfhi(w.w);
}

namespace pg8 {
constexpr int BM = 256, BK = 64, HALF = 128, HTB = HALF * BK * 2, STAGE_BYTES = 8 * HTB, NXCD = 8, WGM = 8;
__host__ __device__ __forceinline__ int lds_byte(int r, int c) { const int st = (r >> 4) * 2 + (c >> 5), rr = r & 15, cc = c & 31, ob = rr * 64 + cc * 2; return st * 1024 + (ob ^ (((ob >> 9) & 1) << 5)); }
__host__ __device__ __forceinline__ void stage_rc(int b, int& R, int& C) { const int st = b / 1024, sb = b % 1024, swz = sb ^ (((sb >> 9) & 1) << 5); R = (st >> 1) * 16 + swz / 64; C = (st & 1) * 32 + (swz % 64) / 2; }
__host__ __device__ __forceinline__ int perm32(int rho) { const int n = rho >> 4, i = rho & 15; return 8 * (i >> 2) + 4 * n + (i & 3); }

struct Unit { int pm, pn; };
struct Gemm { const bf16_t* A; const bf16_t* Bt; int M, N, K, lda; };

struct StaticOrder {
    int nM, nN, nwg, G, c;
    __device__ void init(int M, int N, int G_, int c_) { nM = M / BM; nN = N / BM; nwg = nM * nN; G = G_; c = c_; }
    __device__ bool next(int i, Unit& u) const {
        const long L = (long)i * G + c; if (L >= nwg) return false;
        int wgid = (int)L; { const int q = nwg / NXCD, r = nwg % NXCD, xcd = wgid % NXCD, off = wgid / NXCD; wgid = (xcd < r ? xcd * (q + 1) : r * (q + 1) + (xcd - r) * q) + off; }
        const int nig = WGM * nN, gid = wgid / nig, fm = gid * WGM, gsz = (nM - fm) < WGM ? (nM - fm) : WGM;
        u.pm = fm + ((wgid % nig) % gsz); u.pn = (wgid % nig) / gsz; return true;
    }
};

struct EpiBf16S {
    bf16_t* O; int ldc; const float* rs; int ncols;
    __device__ __forceinline__ void operator()(const f32x4 (&acc)[2][2][4][2], const Unit& u, int wr, int wc, int fr, int fq) const {
        const int row0 = u.pm * BM + wr * 64 + fr, col0 = u.pn * BM + wc * 32 + 8 * fq;
#pragma unroll
        for (int ai = 0; ai < 2; ++ai)
#pragma unroll
            for (int m = 0; m < 4; ++m) {
                const int row = row0 + ai * HALF + m * 16; const float s = rs ? rs[row] : 1.f;
#pragma unroll
                for (int bj = 0; bj < 2; ++bj) { const int col = col0 + bj * HALF;
                    if (col < ncols) { const f32x4 v0 = acc[ai][bj][m][0] * s, v1 = acc[ai][bj][m][1] * s; u32x4 w;
                        w.x = cvtpk(v0[0], v0[1]); w.y = cvtpk(v0[2], v0[3]); w.z = cvtpk(v1[0], v1[1]); w.w = cvtpk(v1[2], v1[3]);
                        *(u32x4*)(O + (size_t)row * ldc + col) = w; } }
            }
    }
};
struct EpiResid1 {
    bf16_t* XB; float* ss; LAS float* racc;
    __device__ __forceinline__ void operator()(const f32x4 (&acc)[2][2][4][2], const Unit& u, int wr, int wc, int fr, int fq) const {
        const int row0 = u.pm * BM + wr * 64 + fr, col0 = u.pn * BM + wc * 32 + 8 * fq;
        const int tid = (wr * 4 + wc) * 64 + fq * 16 + fr;
        if (tid < 256) racc[tid] = 0.f;
        asm volatile("s_waitcnt lgkmcnt(0)" ::: "memory"); __builtin_amdgcn_s_barrier();
#pragma unroll
        for (int ai = 0; ai < 2; ++ai)
#pragma unroll
            for (int m = 0; m < 4; ++m) {
                const int row = row0 + ai * HALF + m * 16; float s = 0.f;
#pragma unroll
                for (int bj = 0; bj < 2; ++bj) { const size_t o = (size_t)row * DM + col0 + bj * HALF;
                    float f[8]; unpack8(*(const u32x4*)(XB + o), f);
                    const f32x4 v0 = acc[ai][bj][m][0] + (f32x4){f[0], f[1], f[2], f[3]}, v1 = acc[ai][bj][m][1] + (f32x4){f[4], f[5], f[6], f[7]};
                    u32x4 w; w.x = cvtpk(v0[0], v0[1]); w.y = cvtpk(v0[2], v0[3]); w.z = cvtpk(v1[0], v1[1]); w.w = cvtpk(v1[2], v1[3]);
                    *(u32x4*)(XB + o) = w;
                    s += v0[0] * v0[0] + v0[1] * v0[1] + v0[2] * v0[2] + v0[3] * v0[3] + v1[0] * v1[0] + v1[1] * v1[1] + v1[2] * v1[2] + v1[3] * v1[3]; }
                s += __shfl_xor(s, 16); s += __shfl_xor(s, 32);
                if (fq == 0) __hip_atomic_fetch_add(racc + (ai * HALF + wr * 64 + m * 16 + fr), s, __ATOMIC_RELAXED, __HIP_MEMORY_SCOPE_WORKGROUP);
            }
        asm volatile("s_waitcnt lgkmcnt(0)" ::: "memory"); __builtin_amdgcn_s_barrier();
        if (tid < 256) atomicAdd(ss + u.pm * BM + tid, racc[tid]);
    }
};
struct EpiSwiGLU {
    bf16_t* ACT; const float* ss;
    __device__ __forceinline__ void operator()(const f32x4 (&acc)[2][2][4][2], const Unit& u, int wr, int wc, int fr, int fq) const {
        const int row0 = u.pm * BM + wr * 64 + fr, col0 = u.pn * HALF + wc * 32 + 8 * fq;
#pragma unroll
        for (int ai = 0; ai < 2; ++ai)
#pragma unroll
            for (int m = 0; m < 4; ++m) {
                const int row = row0 + ai * HALF + m * 16; const float rs = rsqrtf(ss[row] * (1.f / DM) + EPS);
                float a[8];
#pragma unroll
                for (int n = 0; n < 2; ++n)
#pragma unroll
                    for (int j = 0; j < 4; ++j) { const float g = acc[ai][0][m][n][j] * rs, up = acc[ai][1][m][n][j] * rs; a[4 * n + j] = siluf(g) * up; }
                u32x4 w; w.x = cvtpk(a[0], a[1]); w.y = cvtpk(a[2], a[3]); w.z = cvtpk(a[4], a[5]); w.w = cvtpk(a[6], a[7]);
                __builtin_nontemporal_store(w, (u32x4*)(ACT + (size_t)row * DFF + col0));
            }
    }
};
struct EpiAccum {
    float* O; const bf16_t* XB;
    __device__ __forceinline__ void operator()(const f32x4 (&acc)[2][2][4][2], const Unit& u, int wr, int wc, int fr, int fq) const {
        const int row0 = u.pm * BM + wr * 64 + fr, col0 = u.pn * BM + wc * 32 + 8 * fq;
#pragma unroll
        for (int ai = 0; ai < 2; ++ai)
#pragma unroll
            for (int m = 0; m < 4; ++m) {
                const int row = row0 + ai * HALF + m * 16;
#pragma unroll
                for (int bj = 0; bj < 2; ++bj) { const size_t o = (size_t)row * DM + col0 + bj * HALF;
                    float f[8]; unpack8(__builtin_nontemporal_load((const u32x4*)(XB + o)), f);
                    __builtin_nontemporal_store(acc[ai][bj][m][0] + (f32x4){f[0], f[1], f[2], f[3]}, (f32x4*)(O + o));
                    __builtin_nontemporal_store(acc[ai][bj][m][1] + (f32x4){f[4], f[5], f[6], f[7]}, (f32x4*)(O + o + 4)); }
            }
    }
};

template <class Epi>
__device__ __forceinline__ void gemm_phase(LAS unsigned char* lds, const Gemm g, const StaticOrder& S, const Epi& E) {
    const int tid = opaque_tid(), wid = __builtin_amdgcn_readfirstlane(tid >> 6), lane = tid & 63, wr = wid >> 2, wc = wid & 3, fr = lane & 15, fq = lane >> 4;
    const int K = g.K, nt = K / BK, lda = g.lda;
    unsigned voffA[2], voffB[2];
#pragma unroll
    for (int i = 0; i < 2; ++i) { int R, C; stage_rc(tid * 16 + i * 8192, R, C); const int Rb = (R & ~31) + perm32(R & 31);
        voffA[i] = (unsigned)(R * lda + C) * 2u; voffB[i] = (unsigned)(Rb * K + C) * 2u; }
    const size_t kstep = (size_t)(BK * 2);
    const size_t hstepA = (size_t)HALF * lda * 2, hstepB = (size_t)HALF * K * 2;
    const size_t tstepA = 2 * hstepA, tstepB = 2 * hstepB;
    const unsigned ldsw = (unsigned)wid * 1024u;
    const int aoff = lds_byte(wr * 64 + fr, fq * 8), boff = lds_byte(wc * 32 + fr, fq * 8);
#define PG8_SA(b, h) (((b) * 2 + (h)) * HTB)
#define PG8_SB(b, h) ((4 + (b) * 2 + (h)) * HTB)
#define PG8_STAGE(bufoff, gbase, voff) do { _Pragma("unroll") for (int _i = 0; _i < 2; ++_i) \
        __builtin_amdgcn_global_load_lds((const unsigned*)((const char*)(gbase) + (voff)[_i]), (LAS unsigned*)(lds + (bufoff) + ldsw + _i * 8192), 16, 0, 0); } while (0)
#define PG8_LDA(dst, b, h) do { _Pragma("unroll") for (int m = 0; m < 4; ++m) _Pragma("unroll") for (int k = 0; k < 2; ++k) dst[m][k] = *(const LAS bf16x8*)(lds + PG8_SA(b, h) + aoff + m * 2048 + k * 1024); } while (0)
#define PG8_LDB(dst, b, h) do { _Pragma("unroll") for (int n = 0; n < 2; ++n) _Pragma("unroll") for (int k = 0; k < 2; ++k) dst[n][k] = *(const LAS bf16x8*)(lds + PG8_SB(b, h) + boff + n * 2048 + k * 1024); } while (0)
#define PG8_MMA(ai, bj, At, Bt) do { __builtin_amdgcn_s_setprio(1); _Pragma("unroll") for (int m = 0; m < 4; ++m) _Pragma("unroll") for (int n = 0; n < 2; ++n) _Pragma("unroll") for (int k = 0; k < 2; ++k) \
        acc[ai][bj][m][n] = __builtin_amdgcn_mfma_f32_16x16x32_bf16(Bt[n][k], At[m][k], acc[ai][bj][m][n], 0, 0, 0); __builtin_amdgcn_s_setprio(0); } while (0)
#define PG8_WAIT_V(n) asm volatile("s_waitcnt vmcnt(" #n ")" ::: "memory")
#define PG8_WAIT_L(n) asm volatile("s_waitcnt lgkmcnt(" #n ")" ::: "memory")
#define PG8_BAR __builtin_amdgcn_s_barrier()
#define PG8_SCHED __builtin_amdgcn_sched_barrier(0)
    Unit cur, nxt; int ui = 0;
    if (!S.next(0, cur)) return;
    f32x4 acc[2][2][4][2];
#pragma unroll
    for (int a = 0; a < 2; ++a)
#pragma unroll
        for (int b = 0; b < 2; ++b)
#pragma unroll
            for (int m = 0; m < 4; ++m)
#pragma unroll
                for (int n = 0; n < 2; ++n) acc[a][b][m][n] = (f32x4){0.f, 0.f, 0.f, 0.f};
    bf16x8 At[4][2], B0[2][2], B1[2][2];
    const char* cA = (const char*)g.A + (size_t)cur.pm * tstepA; const char* cB = (const char*)g.Bt + (size_t)cur.pn * tstepB;
    PG8_STAGE(PG8_SB(0, 0), cB, voffB); PG8_STAGE(PG8_SB(0, 1), cB + hstepB, voffB); PG8_STAGE(PG8_SA(0, 0), cA, voffA); PG8_STAGE(PG8_SA(0, 1), cA + hstepA, voffA);
    if (wr == 1) PG8_BAR;
    PG8_WAIT_V(2); PG8_BAR;
    PG8_STAGE(PG8_SB(1, 0), cB + kstep, voffB); PG8_STAGE(PG8_SA(1, 0), cA + kstep, voffA); PG8_STAGE(PG8_SB(1, 1), cB + hstepB + kstep, voffB);
    PG8_WAIT_V(6); PG8_BAR;
    for (;;) {
        const bool has_next = S.next(ui + 1, nxt);
        const char* nA = has_next ? (const char*)g.A + (size_t)nxt.pm * tstepA : cA; const char* nB = has_next ? (const char*)g.Bt + (size_t)nxt.pn * tstepB : cB;
        for (int t = 0; t < nt; t += 2) {
            const bool last = (t == nt - 2);
            const char* a1 = cA + (size_t)(t + 1) * kstep;
            const char* a2 = last ? nA : cA + (size_t)(t + 2) * kstep; const char* b2 = last ? nB : cB + (size_t)(t + 2) * kstep;
            const char* a3 = a2 + kstep; const char* b3 = b2 + kstep;
            PG8_LDB(B0, 0, 0); PG8_LDB(B1, 0, 1); PG8_SCHED; PG8_LDA(At, 0, 0); PG8_STAGE(PG8_SA(1, 1), a1 + hstepA, voffA);
            PG8_WAIT_V(8); PG8_WAIT_L(0); PG8_BAR; PG8_MMA(0, 0, At, B0); PG8_MMA(0, 1, At, B1); PG8_BAR; PG8_SCHED;
            PG8_LDA(At, 0, 1); PG8_STAGE(PG8_SB(0, 0), b2, voffB); PG8_STAGE(PG8_SB(0, 1), b2 + hstepB, voffB); PG8_STAGE(PG8_SA(0, 0), a2, voffA);
            PG8_WAIT_V(8); PG8_WAIT_L(0); PG8_BAR; PG8_MMA(1, 0, At, B0); PG8_MMA(1, 1, At, B1); PG8_BAR; PG8_SCHED;
            PG8_LDB(B0, 1, 0); PG8_LDB(B1, 1, 1); PG8_SCHED; PG8_LDA(At, 1, 0); PG8_STAGE(PG8_SA(0, 1), a2 + hstepA, voffA);
            PG8_WAIT_V(8); PG8_WAIT_L(0); PG8_BAR; PG8_MMA(0, 0, At, B0); PG8_MMA(0, 1, At, B1); PG8_BAR; PG8_SCHED;
            PG8_LDA(At, 1, 1); PG8_STAGE(PG8_SB(1, 0), b3, voffB); PG8_STAGE(PG8_SB(1, 1), b3 + hstepB, voffB); PG8_STAGE(PG8_SA(1, 0), a3, voffA);
            PG8_WAIT_V(8); PG8_WAIT_L(0); PG8_BAR; PG8_MMA(1, 0, At, B0); PG8_MMA(1, 1, At, B1); PG8_BAR; PG8_SCHED;
        }
        if (wr == 0) PG8_BAR;
        E(acc, cur, wr, wc, fr, fq);
        if (!has_next) break;
#pragma unroll
        for (int a = 0; a < 2; ++a)
#pragma unroll
            for (int b = 0; b < 2; ++b)
#pragma unroll
                for (int m = 0; m < 4; ++m)
#pragma unroll
                    for (int n = 0; n < 2; ++n) acc[a][b][m][n] = (f32x4){0.f, 0.f, 0.f, 0.f};
        cur = nxt; cA = nA; cB = nB; ++ui;
        if (wr == 1) PG8_BAR;
    }
    PG8_WAIT_V(0);
    PG8_BAR;
#undef PG8_SA
#undef PG8_SB
#undef PG8_STAGE
#undef PG8_LDA
#undef PG8_LDB
#undef PG8_MMA
#undef PG8_WAIT_V
#undef PG8_WAIT_L
#undef PG8_BAR
#undef PG8_SCHED
}
}

__device__ __forceinline__ void transpose_item(const float* W, int K, int N, bf16_t* WT, int k0, int n0, int orow0, const float* ksc, LAS float* scr, int lane) {
    const int c4 = lane & 15, kr = lane >> 4;
    f32x4 v[16];
#pragma unroll
    for (int i = 0; i < 16; ++i) v[i] = __builtin_nontemporal_load((const f32x4*)(W + (size_t)(k0 + 4 * i + kr) * N + n0 + 4 * c4));
#pragma unroll
    for (int i = 0; i < 16; ++i) { const int kk = 4 * i + kr; const float sc = ksc ? ksc[k0 + kk] : 1.f; LAS float* d = scr + kk * 65 + 4 * c4;
        d[0] = v[i][0] * sc; d[1] = v[i][1] * sc; d[2] = v[i][2] * sc; d[3] = v[i][3] * sc; }
    asm volatile("s_waitcnt lgkmcnt(0)" ::: "memory");
    const int c = lane & 7;
#pragma unroll
    for (int j = 0; j < 8; ++j) { const int n = (lane >> 3) + 8 * j; const LAS float* sp = scr + (8 * c) * 65 + n;
        u32x4 o; o.x = cvtpk(sp[0 * 65], sp[1 * 65]); o.y = cvtpk(sp[2 * 65], sp[3 * 65]); o.z = cvtpk(sp[4 * 65], sp[5 * 65]); o.w = cvtpk(sp[6 * 65], sp[7 * 65]);
        *(u32x4*)(WT + (size_t)(orow0 + n) * K + k0 + 8 * c) = o; }
    asm volatile("s_waitcnt lgkmcnt(0)" ::: "memory");
}
constexpr int I_IN = (DM / 64) * (DIN / 64), I_UQ = (QL / 64) * (MH * QKD / 64), I_UKV = (KVL / 64) * (2048 / 64), I_OUT = (DM / 64) * (DM / 64),
              I_GU = (DM / 64) * (2 * DFF / 64), I_DN = (DFF / 64) * (DM / 64);
constexpr int IT_EARLY = I_IN + I_UQ + I_UKV, IT_ALL = IT_EARLY + I_OUT + I_GU + I_DN;
__device__ __forceinline__ void convert_range(const Params& p, LAS unsigned char* lds, int lo, int hi, int gw, int NGW, int wave, int lane) {
    unsigned char* ws = p.ws;
    LAS float* scr = (LAS float*)(lds + wave * 16640);
    bf16_t* Wt_in = (bf16_t*)(ws + WS_WIN); bf16_t* Wt_gu = (bf16_t*)(ws + WS_WGU); bf16_t* Wt_dn = (bf16_t*)(ws + WS_WDN);
    bf16_t* Wt_out = (bf16_t*)(ws + WS_WOUT); bf16_t* Wt_uq = (bf16_t*)(ws + WS_WUQ); bf16_t* Wt_ukv = (bf16_t*)(ws + WS_WUKV);
    for (int it = lo + gw; it < hi; it += NGW) {
        int r = it; const float* W; const float* ksc; bf16_t* WT; int K, N, nb; bool gu = false;
        if (r < I_IN) { W = p.w_in; K = DM; N = DIN; WT = Wt_in; ksc = p.attn_norm_w; }
        else if ((r -= I_IN) < I_UQ) { W = p.w_uq; K = QL; N = MH * QKD; WT = Wt_uq; ksc = p.q_norm_w; }
        else if ((r -= I_UQ) < I_UKV) { W = p.w_ukv; K = KVL; N = 2048; WT = Wt_ukv; ksc = p.kv_norm_w; }
        else if ((r -= I_UKV) < I_OUT) { W = p.w_out; K = DM; N = DM; WT = Wt_out; ksc = nullptr; }
        else if ((r -= I_OUT) < I_GU) { W = p.w_gu; K = DM; N = 2 * DFF; WT = Wt_gu; ksc = p.ffn_norm_w; gu = true; }
        else { r -= I_GU; W = p.w_dn; K = DFF; N = DM; WT = Wt_dn; ksc = nullptr; }
        nb = N / 64; const int n0 = 64 * (r % nb), k0 = 64 * (r / nb);
        const int orow = !gu ? n0 : ((n0 < DFF) ? (256 * (n0 / 128) + (n0 % 128)) : (256 * ((n0 - DFF) / 128) + 128 + ((n0 - DFF) % 128)));
        transpose_item(W, K, N, WT, k0, n0, orow, ksc, scr, lane);
    }
}

__device__ __forceinline__ void p0_prep(const Params& p, LAS unsigned char* lds) {
    const int tid = opaque_tid(), lane = tid & 63, wave = tid >> 6;
    const int G = gridDim.x, gw = blockIdx.x * 8 + wave, NGW = G * 8;
    unsigned char* ws = p.ws;
    bf16_t* Wt_in = (bf16_t*)(ws + WS_WIN);
    convert_range(p, lds, 0, IT_EARLY, gw, NGW, wave, lane);
    { const int gt = blockIdx.x * 512 + tid, NT = G * 512; u32x4* z = (u32x4*)(Wt_in + (size_t)DIN * DM); const int n16 = (DINP - DIN) * DM * 2 / 16;
      for (int i = gt; i < n16; i += NT) z[i] = (u32x4){0u, 0u, 0u, 0u};
      float* ss2 = (float*)(ws + WS_SS2); for (int i = gt; i < T; i += NT) ss2[i] = 0.f;
      float* lbT = (float*)(ws + WS_LB); for (int i = gt; i < HGW; i += NT) lbT[i] = 1.f / (1.f + __expf(p.hgrn_lb[HGW + i] - p.hgrn_lb[i]));
      float* cosT = (float*)(ws + WS_ROPE); float* sinT = cosT + (size_t)T * 32;
      for (int i = gt; i < T * 32; i += NT) { const int t = i >> 5, f = i & 31;
          const float invf = (float)exp(-(double)f * (9.210340371976184 / 32.0));
          const float ang = (float)p.pos[t] * invf;
          const double xd = (double)ang; const double kq = rint(xd * 0.6366197723675814); const double rr = xd - kq * 1.5707963267948966;
          const double r2 = rr * rr;
          const double sn = rr * (1.0 + r2 * (-1.0 / 6 + r2 * (1.0 / 120 + r2 * (-1.0 / 5040 + r2 * (1.0 / 362880 + r2 * (-1.0 / 39916800))))));
          const double cs = 1.0 + r2 * (-0.5 + r2 * (1.0 / 24 + r2 * (-1.0 / 720 + r2 * (1.0 / 40320 + r2 * (-1.0 / 3628800 + r2 * (1.0 / 479001600))))));
          const int q = ((int)kq) & 3; double c, s;
          if (q == 0) { c = cs; s = sn; } else if (q == 1) { c = -sn; s = cs; } else if (q == 2) { c = -cs; s = -sn; } else { c = sn; s = -cs; }
          cosT[i] = (float)c; sinT[i] = (float)s; }
    }
    bf16_t* xb = (bf16_t*)(ws + WS_XB); float* rs1 = (float*)(ws + WS_RS1);
    for (int m = gw; m < T; m += 2 * NGW) {
        const int m2 = (m + NGW < T) ? m + NGW : m;
        const f32x4* xr = (const f32x4*)(p.x + (size_t)m * DM) + lane; const f32x4* xr2 = (const f32x4*)(p.x + (size_t)m2 * DM) + lane; f32x4 v[8], v2[8]; float s = 0.f, s2 = 0.f;
#pragma unroll
        for (int j = 0; j < 8; ++j) { v[j] = __builtin_nontemporal_load(xr + 64 * j); v2[j] = __builtin_nontemporal_load(xr2 + 64 * j); }
#pragma unroll
        for (int j = 0; j < 8; ++j) { s += v[j][0] * v[j][0] + v[j][1] * v[j][1] + v[j][2] * v[j][2] + v[j][3] * v[j][3]; s2 += v2[j][0] * v2[j][0] + v2[j][1] * v2[j][1] + v2[j][2] * v2[j][2] + v2[j][3] * v2[j][3]; }
        s = wave_sum(s); s2 = wave_sum(s2);
        u32x2* o = (u32x2*)(xb + (size_t)m * DM) + lane; u32x2* o2 = (u32x2*)(xb + (size_t)m2 * DM) + lane;
#pragma unroll
        for (int j = 0; j < 8; ++j) { u32x2 w; w.x = cvtpk(v[j][0], v[j][1]); w.y = cvtpk(v[j][2], v[j][3]); o[64 * j] = w; w.x = cvtpk(v2[j][0], v2[j][1]); w.y = cvtpk(v2[j][2], v2[j][3]); o2[64 * j] = w; }
        if (lane == 0) { rs1[m] = rsqrtf(s * (1.f / DM) + EPS); rs1[m2] = rsqrtf(s2 * (1.f / DM) + EPS); }
    }
}

constexpr int H_LF = 0;
constexpr int H_SEG = 33024;
constexpr int H_VT = H_SEG + 2048;
constexpr int H_KT = H_VT + 18432;
constexpr int H_SS = H_KT + 18432;
static_assert(H_SS + 2048 <= 131072, "hgrn lds");

__device__ __forceinline__ void hgrn_pass_a(const Params& p, LAS unsigned char* lds, int u) {
    const int tid = opaque_tid(), lane = tid & 63, wave = __builtin_amdgcn_readfirstlane(tid >> 6), r = lane & 31, hi = lane >> 5;
    const int bh = u >> 7, c = u & 127, b = bh >> 3, h = bh & 7, tok0 = b * SEQ + c * CHUNK;
    bf16_t* proj = (bf16_t*)(p.ws + WS_PROJ);
    bf16_t* states = (bf16_t*)((unsigned char*)p.out + OUT_ST); float* dec = (float*)(p.ws + WS_DEC); float* emid = (float*)(p.ws + WS_EMID);
    const float* lbT = (const float*)(p.ws + WS_LB);
    LAS float* LF = (LAS float*)(lds + H_LF); LAS float* SEG = (LAS float*)(lds + H_SEG);
    LAS unsigned short* VT = (LAS unsigned short*)(lds + H_VT); LAS unsigned short* KT = (LAS unsigned short*)(lds + H_KT);
    const int ch = (tid & 3) + 4 * (tid >> 8), t = (tid >> 2) & 63, d0 = 16 * ch;
    bf16_t* rowp = proj + (size_t)(tok0 + t) * DIN + h * 128 + d0;
    const u32x4 i0 = *(const u32x4*)(rowp + 2048), i1 = *(const u32x4*)(rowp + 2048 + 8);
    const u32x4 q0 = *(const u32x4*)(rowp), q1 = *(const u32x4*)(rowp + 8);
    const u32x4 f0 = *(const u32x4*)(rowp + 1024), f1 = *(const u32x4*)(rowp + 1024 + 8);
    bf16_t* tile = proj + (size_t)tok0 * DIN + h * 128;
    float kf[16];
    { float f[16]; unpack8(f0, f); unpack8(f1, f + 8);
#pragma unroll
      for (int j = 0; j < 16; ++j) { const float lb = lbT[h * 128 + d0 + j]; const float fg = lb + (1.f - lb) * sigmoidf_(f[j]); kf[j] = 1.f - fg; LF[t * 129 + d0 + j] = __logf(fg); } }
    asm volatile("s_waitcnt vmcnt(0)" ::: "memory");
    __syncthreads();
    { const int d = tid & 127, seg = tid >> 7; float run = 0.f;
#pragma unroll
      for (int j = 0; j < 16; ++j) { run += LF[(16 * seg + j) * 129 + d]; LF[(16 * seg + j) * 129 + d] = run; }
      SEG[seg * 128 + d] = run;
      __syncthreads();
      float off = 0.f;
      for (int s2 = 0; s2 < seg; ++s2) off += SEG[s2 * 128 + d];
      if (seg > 0) {
#pragma unroll
          for (int j = 0; j < 16; ++j) LF[(16 * seg + j) * 129 + d] += off; } }
    __syncthreads();
    { float q[16]; unpack8(q0, q); unpack8(q1, q + 8);
      const unsigned iv[8] = {i0.x, i0.y, i0.z, i0.w, i1.x, i1.y, i1.z, i1.w};
      float qt[16], kp[16];
#pragma unroll
      for (int j = 0; j < 16; ++j) { const int dl = d0 + j; const float bt = LF[t * 129 + dl], bm = LF[31 * 129 + dl];
          qt[j] = siluf(q[j]) * __expf(bt - bm); kp[j] = kf[j] * __expf(bm - bt);
          KT[dl * 72 + t] = (unsigned short)(cvtpk(kp[j], 0.f) & 0xffffu);
          VT[dl * 72 + t] = (unsigned short)((j & 1) ? (iv[j >> 1] >> 16) : (iv[j >> 1] & 0xffffu)); }
#pragma unroll
      for (int k = 0; k < 2; ++k) { u32x4 w;
          w.x = cvtpk(qt[8 * k], qt[8 * k + 1]); w.y = cvtpk(qt[8 * k + 2], qt[8 * k + 3]); w.z = cvtpk(qt[8 * k + 4], qt[8 * k + 5]); w.w = cvtpk(qt[8 * k + 6], qt[8 * k + 7]);
          { const int n = (((t >> 5) * 8 + ch) * 2 + k) * 32 + (t & 31); *(u32x4*)(tile + (size_t)(n >> 4) * DIN + (n & 15) * 8) = w; }
          w.x = cvtpk(kp[8 * k], kp[8 * k + 1]); w.y = cvtpk(kp[8 * k + 2], kp[8 * k + 3]); w.z = cvtpk(kp[8 * k + 4], kp[8 * k + 5]); w.w = cvtpk(kp[8 * k + 6], kp[8 * k + 7]);
          { const int n = (((t >> 5) * 8 + ch) * 2 + k) * 32 + pi32(t & 31); *(u32x4*)(tile + (size_t)(n >> 4) * DIN + 1024 + (n & 15) * 8) = w; } } }
    if (tid < 128) { dec[(size_t)u * 128 + tid] = __expf(LF[63 * 129 + tid]); emid[(size_t)u * 128 + tid] = __expf(LF[31 * 129 + tid]); }
    __syncthreads();
    { const int vb = wave >> 1;
#pragma unroll
      for (int q = 0; q < 2; ++q) { const int db = 2 * (wave & 1) + q; f32x16 acc;
#pragma unroll
          for (int i = 0; i < 16; ++i) acc[i] = 0.f;
#pragma unroll
          for (int ks = 0; ks < 4; ++ks) { const bf16x8 a = *(const LAS bf16x8*)(VT + (32 * vb + r) * 72 + 16 * ks + 8 * hi);
              const bf16x8 bb = *(const LAS bf16x8*)(KT + (32 * db + r) * 72 + 16 * ks + 8 * hi); acc = MFMA32(a, bb, acc); }
          const float sc = __expf(LF[63 * 129 + 32 * db + r] - LF[31 * 129 + 32 * db + r]);
          const int dd = 32 * db + r; bf16_t* o = states + (size_t)u * 16384 + ((((vb * 8 + (dd >> 4)) * 2 + ((dd >> 3) & 1)) * 32) * 8) + (dd & 7);
#pragma unroll
          for (int i = 0; i < 16; ++i) o[crow(i, hi) * 8] = (bf16_t)(cvtpk(acc[i] * sc, 0.f) & 0xffffu); }
#pragma unroll
      for (int i = 0; i < 2; ++i) { const int q = tid + 512 * i, v = q >> 3, s8 = q & 7, n = (((v >> 5) * 4 + (s8 >> 1)) * 2 + (s8 & 1)) * 32 + (v & 31);
          const u32x4 w = *(const LAS u32x4*)(VT + v * 72 + 8 * s8);
          *(u32x4*)(tile + (size_t)(n >> 4) * DIN + 2048 + (n & 15) * 8) = w; } }
    __syncthreads();
}

__device__ __forceinline__ void hgrn_pass_c(const Params& p, LAS unsigned char* wl  , int u) {
    const int tid = opaque_tid(), lane = tid & 63, r = lane & 31, hi = lane >> 5;
    const int bh = u >> 7, c = u & 127, b = bh >> 3, h = bh & 7, tok0 = b * SEQ + c * CHUNK;
    const bf16_t* proj = (const bf16_t*)(p.ws + WS_PROJ);
    const bf16_t* states = (const bf16_t*)((unsigned char*)p.out + OUT_ST); bf16_t* mix = (bf16_t*)(p.ws + WS_MIX);
    const __amdgpu_buffer_rsrc_t rp = __builtin_amdgcn_make_buffer_rsrc((void*)(p.ws + WS_PROJ), 0, 0x7fffffff, 0x00020000);
    const __amdgpu_buffer_rsrc_t rst = __builtin_amdgcn_make_buffer_rsrc((void*)p.out, 0, 0x7fffffff, 0x00020000);
    const unsigned loff = (unsigned)((lane >> 4) * DIN + (lane & 15) * 8) * 2u;
    const int uoff = (tok0 * DIN + h * 128) * 2;
#define HG_CHUNK(colbase, n) __builtin_bit_cast(bf16x8, __builtin_amdgcn_raw_buffer_load_b128(rp, loff, uoff + ((((n) - lane) >> 4) * (DIN * 2) + (colbase) * 2), 2))
#pragma unroll 1
    for (int tb = 0; tb < 2; ++tb) {
        bf16x8 bq[8], kf0[8], kf1[8], vt[4][4]; bf16x8 pb[4];
#pragma unroll
        for (int ks = 0; ks < 8; ++ks) { bq[ks] = HG_CHUNK(0, (tb * 8 + ks) * 64 + lane); kf0[ks] = HG_CHUNK(1024, ks * 64 + lane); }
#pragma unroll
        for (int vb = 0; vb < 4; ++vb)
#pragma unroll
            for (int kk = 0; kk < 2; ++kk) vt[vb][kk] = HG_CHUNK(2048, (vb * 4 + kk) * 64 + lane);
        if (tb == 1) {
#pragma unroll
            for (int ks = 0; ks < 8; ++ks) kf1[ks] = HG_CHUNK(1024, (8 + ks) * 64 + lane);
#pragma unroll
            for (int vb = 0; vb < 4; ++vb)
#pragma unroll
                for (int kk = 2; kk < 4; ++kk) vt[vb][kk] = HG_CHUNK(2048, (vb * 4 + kk) * 64 + lane);
        } else {
#pragma unroll
            for (int ks = 0; ks < 8; ++ks) kf1[ks] = kf0[ks];
#pragma unroll
            for (int vb = 0; vb < 4; ++vb) { vt[vb][2] = vt[vb][0]; vt[vb][3] = vt[vb][1]; }
        }
        __builtin_amdgcn_sched_barrier(0);
        {   f32x16 sc;
#pragma unroll
            for (int i = 0; i < 16; ++i) sc[i] = 0.f;
#pragma unroll
            for (int ks = 0; ks < 8; ++ks) sc = MFMA32(kf0[ks], bq[ks], sc);
            if (tb == 0) {
#pragma unroll
                for (int i = 0; i < 16; ++i) if (pi32(crow(i, hi)) > r) sc[i] = 0.f; }
            pb[0] = pack8(sc, 0); pb[1] = pack8(sc, 1);
#pragma unroll
            for (int i = 0; i < 16; ++i) sc[i] = 0.f;
#pragma unroll
            for (int ks = 0; ks < 8; ++ks) sc = MFMA32(kf1[ks], bq[ks], sc);
#pragma unroll
            for (int i = 0; i < 16; ++i) if (tb == 0 || pi32(crow(i, hi)) > r) sc[i] = 0.f;
            pb[2] = pack8(sc, 0); pb[3] = pack8(sc, 1);
        }
        f32x16 o[4];
#pragma unroll
        for (int vb = 0; vb < 4; ++vb) {
#pragma unroll
            for (int i = 0; i < 16; ++i) o[vb][i] = 0.f;
#pragma unroll
            for (int kk = 0; kk < 4; ++kk) o[vb] = MFMA32(vt[vb][kk], pb[kk], o[vb]);
        }
        if (c > 0) {
#pragma unroll
            for (int vh = 0; vh < 2; ++vh) { bf16x8 st[2][8];
#pragma unroll
                for (int v2 = 0; v2 < 2; ++v2) { const int so = (u - 1) * 32768 + (2 * vh + v2) * 8192;
#pragma unroll
                    for (int ks = 0; ks < 8; ++ks) st[v2][ks] = __builtin_bit_cast(bf16x8, __builtin_amdgcn_raw_buffer_load_b128(rst, (unsigned)lane * 16u, so + ks * 1024, 2)); }
                __builtin_amdgcn_sched_barrier(0);
#pragma unroll
                for (int v2 = 0; v2 < 2; ++v2)
#pragma unroll
                    for (int ks = 0; ks < 8; ++ks) o[2 * vh + v2] = MFMA32(st[v2][ks], bq[ks], o[2 * vh + v2]); }
        }
        float ss = 0.f;
#pragma unroll
        for (int vb = 0; vb < 4; ++vb)
#pragma unroll
            for (int i = 0; i < 16; ++i) ss += o[vb][i] * o[vb][i];
        ss += __shfl_xor(ss, 32);
        const float rs = rsqrtf(ss * (1.f / HDV) + EPS);
        { const bf16_t* gbase = proj + (size_t)(tok0 + 32 * tb) * DIN + 3072 + h * 128;
#pragma unroll
          for (int i = 0; i < 8; ++i) { const int row = 4 * i + (lane >> 4), c16 = lane & 15; const u32x4 gv = __builtin_nontemporal_load((const u32x4*)(gbase + (size_t)row * DIN + c16 * 8));
              *(LAS u32x2*)(wl + row * 264 + c16 * 16) = (u32x2){gv.x, gv.y}; *(LAS u32x2*)(wl + row * 264 + c16 * 16 + 8) = (u32x2){gv.z, gv.w}; } }
#pragma unroll
        for (int vb = 0; vb < 4; ++vb)
#pragma unroll
            for (int g = 0; g < 4; ++g) { const int v = 32 * vb + 8 * g + 4 * hi; LAS u32x2* cell = (LAS u32x2*)(wl + r * 264 + v * 2);
                const u32x2 gw = *cell; const f32x4 nw = *(const f32x4*)(p.hgrn_norm_w + v);
                const float o0 = o[vb][4 * g] * rs * nw[0] * siluf(bflo(gw.x)), o1 = o[vb][4 * g + 1] * rs * nw[1] * siluf(bfhi(gw.x));
                const float o2 = o[vb][4 * g + 2] * rs * nw[2] * siluf(bflo(gw.y)), o3 = o[vb][4 * g + 3] * rs * nw[3] * siluf(bfhi(gw.y));
                u32x2 w; w.x = cvtpk(o0, o1); w.y = cvtpk(o2, o3); *cell = w; }
        { bf16_t* obase = mix + (size_t)(tok0 + 32 * tb) * DM + h * 128;
#pragma unroll
          for (int i = 0; i < 8; ++i) { const int row = 4 * i + (lane >> 4), c16 = lane & 15;
              const u32x2 lo = *(const LAS u32x2*)(wl + row * 264 + c16 * 16), hi2 = *(const LAS u32x2*)(wl + row * 264 + c16 * 16 + 8);
              *(u32x4*)(obase + (size_t)row * DM + c16 * 8) = (u32x4){lo.x, lo.y, hi2.x, hi2.y}; } }
    }
#undef HG_CHUNK
}

__device__ __forceinline__ void hgrn_scan(const Params& p) {
    bf16_t* states = (bf16_t*)((unsigned char*)p.out + OUT_ST); const float* dec = (const float*)(p.ws + WS_DEC); const float* emid = (const float*)(p.ws + WS_EMID);
    const int gt = blockIdx.x * 512 + opaque_tid(), NT = gridDim.x * 512;
    for (int pr = gt; pr < 16 * 8192; pr += NT) { const int bh = pr >> 13, e = (pr & 8191) * 2, d = ((e >> 9) & 7) * 16 + ((e >> 8) & 1) * 8 + (e & 7);
        float s0 = 0.f, s1 = 0.f;
        for (int c0 = 0; c0 < NCH; c0 += 16) {
            unsigned L[16]; f32x2_t dd[16], em[16];
#pragma unroll
            for (int j = 0; j < 16; ++j) { const size_t u = (size_t)bh * NCH + c0 + j; const size_t un = (u + 1 < 2048) ? u + 1 : u;
                L[j] = *(const unsigned*)(states + u * 16384 + e); dd[j] = *(const f32x2_t*)(dec + u * 128 + d); em[j] = *(const f32x2_t*)(emid + un * 128 + d); }
#pragma unroll
            for (int j = 0; j < 16; ++j) { s0 = dd[j][0] * s0 + bflo(L[j]); s1 = dd[j][1] * s1 + bfhi(L[j]); L[j] = cvtpk(s0 * em[j][0], s1 * em[j][1]); }
#pragma unroll
            for (int j = 0; j < 16; ++j) { const size_t u = (size_t)bh * NCH + c0 + j; *(unsigned*)(states + u * 16384 + e) = L[j]; }
        } }
}

constexpr int P3_VL = 0;
__device__ __forceinline__ float red8(float v) { v += __shfl_xor(v, 1); v += __shfl_xor(v, 2); v += __shfl_xor(v, 4); return v; }
__device__ __forceinline__ void p3_tile(const Params& p, LAS unsigned char* lds, int tile) {
    const int tid = opaque_tid();
    const int g = tid >> 3, j = tid & 7;
    const int tok0 = tile * 64, b = tok0 / SEQ, s0 = tok0 % SEQ, t = tok0 + g;
    const bf16_t* proj = (const bf16_t*)(p.ws + WS_PROJ); const bf16_t* kvraw = (const bf16_t*)(p.ws + WS_MIX);
    bf16_t* Kn = (bf16_t*)(p.ws + WS_KN); bf16_t* Vt = (bf16_t*)(p.ws + WS_VT);
    const float* cosT = (const float*)(p.ws + WS_ROPE); const float* sinT = cosT + (size_t)T * 32;
    LAS unsigned short* VL = (LAS unsigned short*)(lds + P3_VL);
    float rsq, rskv, skr, kr[8];
    { const bf16_t* rowp = proj + (size_t)t * DIN; float sq = 0.f, skv = 0.f;
#pragma unroll 2
      for (int i = 0; i < 8; ++i) { float f[8]; unpack8(__builtin_nontemporal_load((const u32x4*)(rowp + 4096 + 8 * (j + 8 * i))), f);
#pragma unroll
          for (int e = 0; e < 8; ++e) sq += f[e] * f[e];
          unpack8(__builtin_nontemporal_load((const u32x4*)(rowp + 4608 + 8 * (j + 8 * i))), f);
#pragma unroll
          for (int e = 0; e < 8; ++e) skv += f[e] * f[e]; }
      unpack8(__builtin_nontemporal_load((const u32x4*)(rowp + 5120 + 8 * j)), kr); skr = 0.f;
#pragma unroll
      for (int e = 0; e < 8; ++e) skr += kr[e] * kr[e];
      rsq = rsqrtf(red8(sq) * (1.f / QL) + EPS); rskv = rsqrtf(red8(skv) * (1.f / KVL) + EPS); skr = red8(skr); }
    if (j == 0) ((float*)(p.ws + WS_RS1))[t] = rsq;
    float cs[8], sn[8];
    { const f32x4 c0 = *(const f32x4*)(cosT + (size_t)t * 32 + 8 * (j & 3)), c1 = *(const f32x4*)(cosT + (size_t)t * 32 + 8 * (j & 3) + 4);
      const f32x4 s0v = *(const f32x4*)(sinT + (size_t)t * 32 + 8 * (j & 3)), s1v = *(const f32x4*)(sinT + (size_t)t * 32 + 8 * (j & 3) + 4);
      const float sg = (j < 4) ? -1.f : 1.f;
#pragma unroll
      for (int e = 0; e < 4; ++e) { cs[e] = c0[e]; cs[4 + e] = c1[e]; sn[e] = sg * s0v[e]; sn[4 + e] = sg * s1v[e]; } }
    u32x4 nk0 = __builtin_nontemporal_load((const u32x4*)(kvraw + (size_t)t * 2048 + 8 * j)), nk1 = __builtin_nontemporal_load((const u32x4*)(kvraw + (size_t)t * 2048 + 64 + 8 * j));
#pragma unroll 1
    for (int hh = 0; hh < 8; ++hh) {
        { const bf16_t* kp = kvraw + (size_t)t * 2048 + hh * 256; bf16_t* ko = Kn + ((size_t)(b * 8 + hh) * SEQ + s0 + g) * QKD; float f0[8], f1[8];
          const u32x4 c0r = nk0, c1r = nk1;
          if (hh < 7) { nk0 = __builtin_nontemporal_load((const u32x4*)(kp + 256 + 8 * j)); nk1 = __builtin_nontemporal_load((const u32x4*)(kp + 256 + 64 + 8 * j)); }
          unpack8(c0r, f0); unpack8(c1r, f1);
          float ss = 0.f;
#pragma unroll
          for (int e = 0; e < 8; ++e) ss += f0[e] * f0[e] + f1[e] * f1[e];
          ss = red8(ss) * rskv * rskv + skr;
          const float rk = rsqrtf(ss * (1.f / QKD) + EPS), rr = rskv * rk;
          const f32x4 wa = *(const f32x4*)(p.kh_w + 8 * j), wb = *(const f32x4*)(p.kh_w + 8 * j + 4), wc = *(const f32x4*)(p.kh_w + 64 + 8 * j), wd = *(const f32x4*)(p.kh_w + 64 + 8 * j + 4);
          const f32x4 we = *(const f32x4*)(p.kh_w + 128 + 8 * j), wf = *(const f32x4*)(p.kh_w + 128 + 8 * j + 4);
          u32x4 w; w.x = cvtpk(f0[0] * rr * wa[0], f0[1] * rr * wa[1]); w.y = cvtpk(f0[2] * rr * wa[2], f0[3] * rr * wa[3]);
          w.z = cvtpk(f0[4] * rr * wb[0], f0[5] * rr * wb[1]); w.w = cvtpk(f0[6] * rr * wb[2], f0[7] * rr * wb[3]); *(u32x4*)(ko + 8 * j) = w;
          w.x = cvtpk(f1[0] * rr * wc[0], f1[1] * rr * wc[1]); w.y = cvtpk(f1[2] * rr * wc[2], f1[3] * rr * wc[3]);
          w.z = cvtpk(f1[4] * rr * wd[0], f1[5] * rr * wd[1]); w.w = cvtpk(f1[6] * rr * wd[2], f1[7] * rr * wd[3]); *(u32x4*)(ko + 64 + 8 * j) = w;
          float a[8], o[8];
#pragma unroll
          for (int e = 0; e < 4; ++e) { a[e] = kr[e] * rk * we[e]; a[4 + e] = kr[4 + e] * rk * wf[e]; }
#pragma unroll
          for (int e = 0; e < 8; ++e) { const float pa = __shfl_xor(a[e], 4); o[e] = a[e] * cs[e] + pa * sn[e]; }
          w.x = cvtpk(o[0], o[1]); w.y = cvtpk(o[2], o[3]); w.z = cvtpk(o[4], o[5]); w.w = cvtpk(o[6], o[7]); *(u32x4*)(ko + 128 + 8 * j) = w; }
    }
#pragma unroll 1
    for (int hh = 0; hh < 8; hh += 4) {
        { const int tl = g, ch = j; u32x4 raw[4][2];
#pragma unroll
          for (int h2 = 0; h2 < 4; ++h2) { const bf16_t* vp = kvraw + (size_t)(tok0 + tl) * 2048 + (hh + h2) * 256 + 128 + 16 * ch; raw[h2][0] = __builtin_nontemporal_load((const u32x4*)vp); raw[h2][1] = __builtin_nontemporal_load((const u32x4*)(vp + 8)); }
#pragma unroll
          for (int h2 = 0; h2 < 4; ++h2)
#pragma unroll
              for (int k = 0; k < 2; ++k) { float f[8]; unpack8(raw[h2][k], f); u32x4 w;
                  w.x = cvtpk(f[0] * rskv, f[1] * rskv); w.y = cvtpk(f[2] * rskv, f[3] * rskv); w.z = cvtpk(f[4] * rskv, f[5] * rskv); w.w = cvtpk(f[6] * rskv, f[7] * rskv);
                  *(LAS u32x4*)(VL + h2 * 8704 + tl * 136 + 16 * ch + 8 * k) = w; } }
        __syncthreads();
        { const int v = tid >> 2, tc = tid & 3;
#pragma unroll
          for (int h2 = 0; h2 < 4; ++h2) { bf16_t* vo = Vt + ((size_t)(b * 8 + hh + h2) * VD + v) * SEQ + s0;
#pragma unroll
              for (int cc = 0; cc < 2; ++cc) { const int tb = 8 * (2 * tc + cc); unsigned e[8];
#pragma unroll
                  for (int j = 0; j < 8; ++j) e[j] = VL[h2 * 8704 + (tb + j) * 136 + v];
                  u32x4 w; w.x = e[0] | (e[1] << 16); w.y = e[2] | (e[3] << 16); w.z = e[4] | (e[5] << 16); w.w = e[6] | (e[7] << 16);
                  *(u32x4*)(vo + tb) = w; } } }
        __syncthreads();
    }
}

constexpr int A_KB = 64 * 400, A_VB = 128 * 144, A_STAGE = A_KB + A_VB;
static_assert(2 * A_STAGE <= 131072, "attn lds");
__device__ __forceinline__ void attn_unit(const Params& p, LAS unsigned char* lds, int bh, int qb, float negB) {
    const int tid = opaque_tid(), lane = tid & 63, wave = __builtin_amdgcn_readfirstlane(tid >> 6), r = lane & 31, hi = lane >> 5;
    const int b = bh >> 3, h = bh & 7;
    const bf16_t* qn = (const bf16_t*)((unsigned char*)p.out + OUT_Q);
    const char* Kg = (const char*)(p.ws + WS_KN) + (size_t)bh * SEQ * QKD * 2; const char* Vg = (const char*)(p.ws + WS_VT) + (size_t)bh * VD * SEQ * 2;
    bf16_t* mix = (bf16_t*)(p.ws + WS_MIX);
    bf16x8 qf[12];
    {
        const int tq = b * SEQ + qb * 256 + wave * 32 + r;
        const bf16_t* qrow = qn + (size_t)tq * 1536 + h * 192 + hi * 8;
        const float rsq = ((const float*)(p.ws + WS_RS1))[tq];
        const float* cosT = (const float*)(p.ws + WS_ROPE) + (size_t)tq * 32; const float* sinT = cosT + (size_t)T * 32;
        const float* qw = p.qh_w; asm volatile("" : "+s"(qw));
        LAS unsigned char* qst = lds + wave * 16640;
#pragma unroll
        for (int i = 0; i < 12; ++i) { const int n = i * 64 + lane, row = n / 24, c = n % 24;
            *(LAS u32x4*)(qst + row * 400 + c * 16) = __builtin_nontemporal_load((const u32x4*)(qn + (size_t)(b * SEQ + qb * 256 + wave * 32 + row) * 1536 + h * 192 + 8 * c)); }
        float ss = 0.f;
#pragma unroll
        for (int ks = 0; ks < 12; ++ks) { qf[ks] = *(const LAS bf16x8*)(qst + r * 400 + ks * 32 + hi * 16); float f[8]; unpack8(__builtin_bit_cast(u32x4, qf[ks]), f);
#pragma unroll
            for (int e = 0; e < 8; ++e) ss += f[e] * f[e]; }
        ss += __shfl_xor(ss, 32); ss *= rsq * rsq;
        const float rr = rsq * rsqrtf(ss * (1.f / QKD) + EPS) * QSCALE;
#pragma unroll
        for (int ks = 0; ks < 12; ++ks) { u32x4 tq4 = __builtin_bit_cast(u32x4, qf[ks]); asm volatile("" : "+v"(tq4)); qf[ks] = __builtin_bit_cast(bf16x8, tq4); }
#pragma unroll
        for (int ks = 0; ks < 8; ++ks) { float f[8]; unpack8(__builtin_bit_cast(u32x4, qf[ks]), f); const f32x4 w0 = *(const f32x4*)(qw + 16 * ks + 8 * hi), w1 = *(const f32x4*)(qw + 16 * ks + 8 * hi + 4);
            u32x4 w; w.x = cvtpk(f[0] * rr * w0[0], f[1] * rr * w0[1]); w.y = cvtpk(f[2] * rr * w0[2], f[3] * rr * w0[3]); w.z = cvtpk(f[4] * rr * w1[0], f[5] * rr * w1[1]); w.w = cvtpk(f[6] * rr * w1[2], f[7] * rr * w1[3]);
            qf[ks] = __builtin_bit_cast(bf16x8, w); }
#pragma unroll
        for (int k2 = 0; k2 < 2; ++k2) {
            float fa[8], fb[8]; unpack8(__builtin_bit_cast(u32x4, qf[8 + k2]), fa); unpack8(__builtin_bit_cast(u32x4, qf[10 + k2]), fb);
            const int d1 = 128 + 16 * k2 + 8 * hi, fi = 16 * k2 + 8 * hi; float oa[8], ob[8];
#pragma unroll
            for (int e = 0; e < 8; ++e) { const float a = fa[e] * rr * qw[d1 + e], bb = fb[e] * rr * qw[d1 + 32 + e]; const float c = cosT[fi + e], sn = sinT[fi + e];
                oa[e] = a * c - bb * sn; ob[e] = a * sn + bb * c; }
            u32x4 w; w.x = cvtpk(oa[0], oa[1]); w.y = cvtpk(oa[2], oa[3]); w.z = cvtpk(oa[4], oa[5]); w.w = cvtpk(oa[6], oa[7]); qf[8 + k2] = __builtin_bit_cast(bf16x8, w);
            w.x = cvtpk(ob[0], ob[1]); w.y = cvtpk(ob[2], ob[3]); w.z = cvtpk(ob[4], ob[5]); w.w = cvtpk(ob[6], ob[7]); qf[10 + k2] = __builtin_bit_cast(bf16x8, w); }
    }
    __syncthreads();
    const int ntiles = 4 * qb + 4, mylast = 4 * qb + (wave >> 1);
    unsigned klo[3], vlo[2];
#pragma unroll
    for (int i = 0; i < 3; ++i) { const int q = tid + 512 * i, row = q / 24, cc = q % 24; klo[i] = row * 400 + cc * 16; }
#pragma unroll
    for (int i = 0; i < 2; ++i) { const int q = tid + 512 * i, v = q >> 3, cc = q & 7; vlo[i] = A_KB + v * 144 + cc * 16; }
    const __amdgpu_buffer_rsrc_t rk = __builtin_amdgcn_make_buffer_rsrc((void*)Kg, 0, 0x7fffffff, 0x00020000);
    const __amdgpu_buffer_rsrc_t rv = __builtin_amdgcn_make_buffer_rsrc((void*)Vg, 0, 0x7fffffff, 0x00020000);
    const unsigned kvo = (unsigned)tid * 16u, vvo = (unsigned)(tid >> 3) * (unsigned)(SEQ * 2) + (unsigned)(tid & 7) * 16u;
    int ktile = 0;
#define AT_LDK(i) __builtin_amdgcn_raw_buffer_load_b128(rk, kvo, ktile * (64 * 384) + (i) * 8192, 0)
#define AT_LDV(i) __builtin_amdgcn_raw_buffer_load_b128(rv, vvo, ktile * 128 + (i) * (64 * SEQ * 2), 0)
    u32x4 kreg[3], vreg[2];
#pragma unroll
    for (int i = 0; i < 3; ++i) kreg[i] = AT_LDK(i);
#pragma unroll
    for (int i = 0; i < 2; ++i) vreg[i] = AT_LDV(i);
#pragma unroll
    for (int i = 0; i < 3; ++i) *(LAS u32x4*)(lds + klo[i]) = kreg[i];
#pragma unroll
    for (int i = 0; i < 2; ++i) *(LAS u32x4*)(lds + vlo[i]) = vreg[i];
    ktile = 1;
#pragma unroll
    for (int i = 0; i < 3; ++i) kreg[i] = AT_LDK(i);
#pragma unroll
    for (int i = 0; i < 2; ++i) vreg[i] = AT_LDV(i);
    __syncthreads();
    f32x16 o[4];
#pragma unroll
    for (int vb = 0; vb < 4; ++vb)
#pragma unroll
        for (int i = 0; i < 16; ++i) o[vb][i] = 0.f;
    float lsum = 0.f;
    const unsigned ka = pi32(r) * 400 + hi * 16, va = A_KB + r * 144 + hi * 16;
    if (wave >= 4) __builtin_amdgcn_s_setprio(1);
    for (int t = 0; t < ntiles; ++t) {
        LAS unsigned char* nb = lds + ((t + 1) & 1) * A_STAGE;
#pragma unroll
        for (int i = 0; i < 3; ++i) *(LAS u32x4*)(nb + klo[i]) = kreg[i];
#pragma unroll
        for (int i = 0; i < 2; ++i) *(LAS u32x4*)(nb + vlo[i]) = vreg[i];
        ktile += (t + 2 < ntiles) ? 1 : 0;
#pragma unroll
        for (int i = 0; i < 3; ++i) kreg[i] = AT_LDK(i);
#pragma unroll
        for (int i = 0; i < 2; ++i) vreg[i] = AT_LDV(i);
        if (t <= mylast) {
            LAS unsigned char* buf = lds + (t & 1) * A_STAGE;
            f32x16 s0, s1; float nbv = negB; asm volatile("" : "+v"(nbv));
#pragma unroll
            for (int i = 0; i < 16; ++i) s0[i] = nbv;
#define AT_RD(j) (*(const LAS bf16x8*)(buf + ((j) < 12 ? ka + (j) * 32 : (j) < 24 ? ka + 32 * 400 + ((j) - 12) * 32 : va + (((j) - 24) & 3) * (32 * 144) + (((j) - 24) >> 2) * 32)))
            bf16x8 fr[8]; bf16x8 pb[4];
#pragma unroll
            for (int j = 0; j < 6; ++j) fr[j] = AT_RD(j);
            __builtin_amdgcn_sched_barrier(0);
#pragma unroll
            for (int j = 0; j < 40; ++j) {
                if (j + 6 < 40) fr[(j + 6) & 7] = AT_RD(j + 6);
                if (j < 12) s0 = MFMA32(fr[j & 7], qf[j], s0);
                else if (j < 24) s1 = MFMA32(fr[j & 7], qf[j - 12], s1);
                else o[(j - 24) & 3] = MFMA32(fr[j & 7], pb[(j - 24) >> 2], o[(j - 24) & 3]);
                if (j >= 13 && j < 21) { const int e = 2 * (j - 13); s0[e] = __builtin_amdgcn_exp2f(s0[e]); s0[e + 1] = __builtin_amdgcn_exp2f(s0[e + 1]); lsum += s0[e] + s0[e + 1]; }
                if (j == 11) {
#pragma unroll
                    for (int i = 0; i < 16; ++i) s1[i] = nbv; }
                if (j == 21) pb[0] = pack8(s0, 0);
                if (j == 22) pb[1] = pack8(s0, 1);
                if (j >= 25 && j < 27) { const int e = 3 * (j - 25);
                    s1[e] = __builtin_amdgcn_exp2f(s1[e]); s1[e + 1] = __builtin_amdgcn_exp2f(s1[e + 1]); s1[e + 2] = __builtin_amdgcn_exp2f(s1[e + 2]); lsum += s1[e] + s1[e + 1] + s1[e + 2]; }
                if (j >= 27 && j < 32) { const int e = 6 + 2 * (j - 27); s1[e] = __builtin_amdgcn_exp2f(s1[e]); s1[e + 1] = __builtin_amdgcn_exp2f(s1[e + 1]); lsum += s1[e] + s1[e + 1]; }
                if (j == 31) { pb[2] = pack8(s1, 0); pb[3] = pack8(s1, 1); }
                __builtin_amdgcn_sched_barrier(0);
            }
#undef AT_RD
        }
        __syncthreads();
    }
#undef AT_LDK
#undef AT_LDV
    if (wave >= 4) __builtin_amdgcn_s_setprio(0);
    lsum += __shfl_xor(lsum, 32);
    const float inv = __builtin_amdgcn_rcpf(lsum);
    {
        LAS unsigned char* ost = lds + wave * 16640;
#pragma unroll
        for (int vb = 0; vb < 4; ++vb)
#pragma unroll
            for (int g = 0; g < 4; ++g) { u32x2 w; w.x = cvtpk(o[vb][4 * g] * inv, o[vb][4 * g + 1] * inv); w.y = cvtpk(o[vb][4 * g + 2] * inv, o[vb][4 * g + 3] * inv);
                *(LAS u32x2*)(ost + r * 264 + (32 * vb + 8 * g + 4 * hi) * 2) = w; }
        bf16_t* ob = mix + (size_t)(b * SEQ + qb * 256 + wave * 32) * DM + 1024 + h * 128;
#pragma unroll
        for (int i = 0; i < 8; ++i) { const int row = 4 * i + (lane >> 4), c16 = lane & 15;
            const u32x2 lo = *(const LAS u32x2*)(ost + row * 264 + c16 * 16), hi2 = *(const LAS u32x2*)(ost + row * 264 + c16 * 16 + 8);
            *(u32x4*)(ob + (size_t)row * DM + c16 * 8) = (u32x4){lo.x, lo.y, hi2.x, hi2.y}; }
    }
    __syncthreads();
}

#define XB_XCNT(j)  (256  + 64 * (j))
#define XB_XSUB(j)  (1280 + 64 * (j))
#define XB_XGEN(j)  (2304 + 64 * (j))
#define XB_TOP      3328
#define XB_TOPGEN   3392
constexpr int XB_LDS = 147456 - 64;
__device__ __forceinline__ unsigned xb_ld(unsigned* p)              { return __hip_atomic_load(p, __ATOMIC_RELAXED, __HIP_MEMORY_SCOPE_AGENT); }
__device__ __forceinline__ unsigned xb_add(unsigned* p, unsigned v) { return __hip_atomic_fetch_add(p, v, __ATOMIC_RELAXED, __HIP_MEMORY_SCOPE_AGENT); }
__device__ __forceinline__ unsigned xb_xcc_id() { return (unsigned)__builtin_amdgcn_s_getreg((3 << 11) | 20) & 0xFu; }
#define XB_SPIN(cond) do { unsigned _sp = 0; while (cond) { __builtin_amdgcn_s_sleep(1); if (++_sp > (1u << 24)) break; } } while (0)
__device__ __forceinline__ void xcd_census_post(unsigned* bar, LAS unsigned char* lds) {
    if (threadIdx.x == 0) { const unsigned x = xb_xcc_id(); ((volatile LAS unsigned*)(lds + XB_LDS))[2] = x; (void)xb_add(&bar[XB_XCNT(x)], 1u); }
}
__device__ __forceinline__ void xcd_census_read(unsigned* bar, LAS unsigned char* lds) {
    if (threadIdx.x == 0) { volatile LAS unsigned* st = (volatile LAS unsigned*)(lds + XB_LDS); const unsigned x = st[2]; unsigned cnt = 0u, mine = 1u;
        for (unsigned j = 0; j < 16; ++j) { const unsigned c = xb_ld(&bar[XB_XCNT(j)]); cnt += (c > 0u) ? 1u : 0u; if (j == x) mine = c; }
        st[0] = mine > 0u ? mine : 1u; st[1] = cnt > 0u ? cnt : 1u; }
    __syncthreads();
}
__device__ __forceinline__ void xcd_barrier(unsigned* bar, LAS unsigned char* lds) {
    asm volatile("s_waitcnt vmcnt(0)" ::: "memory");
    __syncthreads();
    if (threadIdx.x == 0) {
        volatile LAS unsigned* st = (volatile LAS unsigned*)(lds + XB_LDS);
        __builtin_amdgcn_s_waitcnt(0);
        const unsigned nloc = st[0], nx = st[1], x = st[2];
        const unsigned old = xb_add(&bar[XB_XSUB(x)], 1u);
        const unsigned gen = old / nloc;
        if (old + 1u == (gen + 1u) * nloc) {
            __builtin_amdgcn_fence(__ATOMIC_RELEASE, "agent");
            asm volatile("s_waitcnt vmcnt(0)" ::: "memory");
            const unsigned og = xb_add(&bar[XB_TOP], 1u);
            const unsigned tg = og / nx;
            if (og + 1u == (tg + 1u) * nx) xb_add(&bar[XB_TOPGEN], 1u);
            else XB_SPIN(xb_ld(&bar[XB_TOPGEN]) == tg);
            __builtin_amdgcn_fence(__ATOMIC_ACQUIRE, "agent");
            xb_add(&bar[XB_XGEN(x)], 1u);
            asm volatile("s_waitcnt vmcnt(0)" ::: "memory");
        } else {
            XB_SPIN(xb_ld(&bar[XB_XGEN(x)]) == gen);
            __builtin_amdgcn_fence(__ATOMIC_ACQUIRE, "agent");
            asm volatile("s_waitcnt vmcnt(0)" ::: "memory");
        }
    }
    __syncthreads();
}

__global__ void __launch_bounds__(512, 2) fwd_mega(Params p) {
    extern __shared__ __attribute__((aligned(16))) unsigned char lds_raw[];
    LAS unsigned char* lds = (LAS unsigned char*)lds_raw;
    cg::grid_group grid = cg::this_grid();
    const int G = gridDim.x, bx = blockIdx.x;
    unsigned char* ws = p.ws;

    unsigned* bar = (unsigned*)(ws + WS_BAR);
    xcd_census_post(bar, lds);
    p0_prep(p, lds);
    grid.sync();
    xcd_census_read(bar, lds);

    { pg8::Gemm g{(const bf16_t*)(ws + WS_XB), (const bf16_t*)(ws + WS_WIN), T, 5120, DM, DM}; pg8::StaticOrder S; S.init(T, 5120, G, bx);
      pg8::EpiBf16S E{(bf16_t*)(ws + WS_PROJ), DIN, (const float*)(ws + WS_RS1), DIN};
      pg8::gemm_phase<pg8::EpiBf16S>(lds, g, S, E); }
    xcd_barrier(bar, lds);

    { const bool bal = (G == 256);
      const int nmine = !bal ? (2048 - bx + G - 1) / G : ((bx < 64 || bx >= 192) ? 9 : 7);
#define P2_PASS_A() do { for (int k = 0; k < nmine; ++k) { const int u = !bal ? bx + G * k : (k < 8 ? bx + 256 * k : (bx < 64 ? bx + 64 : bx - 64) + 1792); hgrn_pass_a(p, lds, u); } } while (0)
      if (bx & 1) P2_PASS_A();
      const int gs = bal ? 192 : G, cs = bal ? bx - 64 : bx;
      if (!bal || bx < 64) { pg8::Gemm g{(const bf16_t*)(ws + WS_XB), (const bf16_t*)(ws + WS_WIN) + (size_t)5120 * DM, T, 256, DM, DM}; pg8::StaticOrder S; S.init(T, 256, bal ? 64 : G, bx);
          pg8::EpiBf16S E{(bf16_t*)(ws + WS_PROJ) + 5120, DIN, (const float*)(ws + WS_RS1), DIN - 5120};
          pg8::gemm_phase<pg8::EpiBf16S>(lds, g, S, E); }
      if (!bal || bx >= 64) {
          { pg8::Gemm g{(const bf16_t*)(ws + WS_PROJ) + 4096, (const bf16_t*)(ws + WS_WUQ), T, MH * QKD, QL, DIN}; pg8::StaticOrder S; S.init(T, MH * QKD, gs, cs);
            pg8::EpiBf16S E{(bf16_t*)((unsigned char*)p.out + OUT_Q), MH * QKD, nullptr, MH * QKD};
            pg8::gemm_phase<pg8::EpiBf16S>(lds, g, S, E); }
          { pg8::Gemm g{(const bf16_t*)(ws + WS_PROJ) + 4608, (const bf16_t*)(ws + WS_WUKV), T, 2048, KVL, DIN}; pg8::StaticOrder S; S.init(T, 2048, gs, cs);
            pg8::EpiBf16S E{(bf16_t*)(ws + WS_MIX), 2048, nullptr, 2048};
            pg8::gemm_phase<pg8::EpiBf16S>(lds, g, S, E); } }
      if (!(bx & 1)) P2_PASS_A();
#undef P2_PASS_A
    }
    xcd_barrier(bar, lds);

    for (int tile = bx; tile < T / 64; tile += G) p3_tile(p, lds, tile);
    hgrn_scan(p);
    xcd_barrier(bar, lds);

    { float mq = 0.f, mk = 0.f; const int lane = opaque_tid() & 63;
      for (int i = lane; i < QKD; i += 64) { mq = fmaxf(mq, fabsf(p.qh_w[i])); mk = fmaxf(mk, fabsf(p.kh_w[i])); }
      mq = wave_max(mq); mk = wave_max(mk);
      const float negB = -(13.856406460551018f * LOG2E) * mq * mk;
      const int wvc = __builtin_amdgcn_readfirstlane(opaque_tid() >> 6); bool cdone = false;
      for (int it = bx; it < 256; it += G) { const int bh = it >> 4, pq = it & 15; const int qa = (bx & 1) ? 31 - pq : pq, qb2 = (bx & 1) ? pq : 31 - pq;
          attn_unit(p, lds, bh, qa, negB);
          if (!cdone) { for (int u = bx * 8 + wvc; u < 2048; u += G * 8) hgrn_pass_c(p, lds + wvc * 16640, u);
              convert_range(p, lds, IT_EARLY, IT_ALL, bx * 8 + wvc, G * 8, wvc, opaque_tid() & 63);
              __syncthreads(); cdone = true; }
          attn_unit(p, lds, bh, qb2, negB); }
      if (!cdone) { for (int u = bx * 8 + wvc; u < 2048; u += G * 8) hgrn_pass_c(p, lds + wvc * 16640, u);
          convert_range(p, lds, IT_EARLY, IT_ALL, bx * 8 + wvc, G * 8, wvc, opaque_tid() & 63); } }
    xcd_barrier(bar, lds);

    { pg8::Gemm g{(const bf16_t*)(ws + WS_MIX), (const bf16_t*)(ws + WS_WOUT), T, DM, DM, DM}; pg8::StaticOrder S; S.init(T, DM, G, bx);
      pg8::EpiResid1 E{(bf16_t*)(ws + WS_XB), (float*)(ws + WS_SS2), (LAS float*)(lds + 131072)};
      pg8::gemm_phase<pg8::EpiResid1>(lds, g, S, E); }
    xcd_barrier(bar, lds);

    { pg8::Gemm g{(const bf16_t*)(ws + WS_XB), (const bf16_t*)(ws + WS_WGU), T, 2 * DFF, DM, DM}; pg8::StaticOrder S; S.init(T, 2 * DFF, G, bx);
      pg8::EpiSwiGLU E{(bf16_t*)(ws + WS_PROJ), (const float*)(ws + WS_SS2)};
      pg8::gemm_phase<pg8::EpiSwiGLU>(lds, g, S, E); }
    xcd_barrier(bar, lds);

    { pg8::Gemm g{(const bf16_t*)(ws + WS_PROJ), (const bf16_t*)(ws + WS_WDN), T, DM, DFF, DFF}; pg8::StaticOrder S; S.init(T, DM, G, bx);
      pg8::EpiAccum E{p.out, (const bf16_t*)(ws + WS_XB)};
      pg8::gemm_phase<pg8::EpiAccum>(lds, g, S, E); }
}

extern "C" void kernel_launch(void* const* d_in, const int* in_sizes, int n_in, void* d_out, int out_size, void* d_ws, size_t ws_size, hipStream_t stream) {
    static int grid = 0;
    if (grid == 0) {
        int dev = 0, cus = 0, per_cu = 0;
        hipGetDevice(&dev);
        hipDeviceGetAttribute(&cus, hipDeviceAttributeMultiprocessorCount, dev);
        hipFuncSetAttribute((const void*)fwd_mega, hipFuncAttributeMaxDynamicSharedMemorySize, LDS_BYTES);
        hipOccupancyMaxActiveBlocksPerMultiprocessor(&per_cu, (const void*)fwd_mega, 512, LDS_BYTES);
        if (per_cu < 1) per_cu = 1;
        grid = cus * per_cu;
        if (ws_size < WS_END) { fprintf(stderr, "kernel_launch: workspace too small (%zu < %zu)\n", ws_size, (size_t)WS_END); grid = -1; }
    }
    if (grid < 0) return;
    Params p{};
    p.x = (const float*)d_in[0]; p.pos = (const int*)d_in[1]; p.attn_norm_w = (const float*)d_in[2]; p.w_in = (const float*)d_in[3];
    p.hgrn_lb = (const float*)d_in[4]; p.hgrn_norm_w = (const float*)d_in[5]; p.q_norm_w = (const float*)d_in[6]; p.w_uq = (const float*)d_in[7];
    p.kv_norm_w = (const float*)d_in[8]; p.w_ukv = (const float*)d_in[9]; p.qh_w = (const float*)d_in[10]; p.kh_w = (const float*)d_in[11];
    p.w_out = (const float*)d_in[12]; p.ffn_norm_w = (const float*)d_in[13]; p.w_gu = (const float*)d_in[14]; p.w_dn = (const float*)d_in[15];
    p.out = (float*)d_out; p.ws = (unsigned char*)d_ws;
    hipMemsetAsync((unsigned char*)d_ws + WS_BAR, 0, 16384, stream);
    void* args[] = {&p};
    hipError_t e = hipLaunchCooperativeKernel((const void*)fwd_mega, dim3(grid), dim3(512), args, LDS_BYTES, stream);
    if (e != hipSuccess) fprintf(stderr, "cooperative launch failed: %s (grid %d)\n", hipGetErrorString(e), grid);
}
```

```cpp
#include <hip/hip_runtime.h>
#include <hip/hip_cooperative_groups.h>
#include <cstdio>
#include <cstdint>
namespace cg = cooperative_groups;

#define LAS __attribute__((address_space(3)))
typedef unsigned short bf16_t;
typedef short bf16x8 __attribute__((ext_vector_type(8)));
typedef float f32x4 __attribute__((ext_vector_type(4)));
typedef float f32x16 __attribute__((ext_vector_type(16)));
typedef unsigned u32x4 __attribute__((ext_vector_type(4)));
typedef unsigned u32x2 __attribute__((ext_vector_type(2)));
typedef float f32x2_t __attribute__((ext_vector_type(2)));
typedef __bf16 bf16x2_t __attribute__((ext_vector_type(2)));

constexpr int DM = 2048, BATCH = 2, SEQ = 8192, T = BATCH * SEQ;
constexpr int CHUNK = 64, NCH = SEQ / CHUNK;
constexpr int HGW = 1024, HGH = 8, HDK = 128, HDV = 128;
constexpr int MH = 8, VD = 128, NOPE = 128, ROPE = 64, QKD = 192, QL = 512, KVL = 512;
constexpr int DFF = 5632;
constexpr int DIN = 5184, DINP = 5376;
constexpr float EPS = 1e-6f;
constexpr float LOG2E = 1.4426950408889634f;
constexpr float QSCALE = 0.07216878364870323f * LOG2E;

constexpr size_t MiB = 1u << 20;
constexpr size_t WS_WIN = 0, WS_WGU = 21 * MiB, WS_WDN = 65 * MiB, WS_WOUT = 87 * MiB, WS_WUQ = 95 * MiB, WS_WUKV = 97 * MiB;
constexpr size_t WS_XB = 100 * MiB;
constexpr size_t WS_PROJ = 164 * MiB;
constexpr size_t WS_KN = 340 * MiB;
constexpr size_t WS_VT = 388 * MiB;
constexpr size_t WS_MIX = 420 * MiB;
constexpr size_t WS_ROPE = 484 * MiB;
constexpr size_t WS_DEC = 488 * MiB;
constexpr size_t WS_RS1 = 489 * MiB;
constexpr size_t WS_SS2 = 489 * MiB + 65536;
constexpr size_t WS_EMID = 490 * MiB;
constexpr size_t WS_LB = 491 * MiB;
constexpr size_t WS_BAR = 491 * MiB + 65536;
constexpr size_t WS_END = 492 * MiB;
constexpr size_t OUT_ST = 0, OUT_Q = 64 * MiB;

constexpr int LDS_BYTES = 147456;

struct Params {
    const float* x; const int* pos; const float* attn_norm_w; const float* w_in; const float* hgrn_lb; const float* hgrn_norm_w;
    const float* q_norm_w; const float* w_uq; const float* kv_norm_w; const float* w_ukv; const float* qh_w; const float* kh_w;
    const float* w_out; const float* ffn_norm_w; const float* w_gu; const float* w_dn;
    float* out; unsigned char* ws;
};

__device__ __forceinline__ int opaque_tid() { int t = threadIdx.x; asm volatile("" : "+v"(t)); return t; }
__device__ __forceinline__ unsigned cvtpk(float lo, float hi) { f32x2_t v = {lo, hi}; bf16x2_t b = __builtin_convertvector(v, bf16x2_t); return __builtin_bit_cast(unsigned, b); }
__device__ __forceinline__ float bflo(unsigned u) { return __uint_as_float(u << 16); }
__device__ __forceinline__ float bfhi(unsigned u) { return __uint_as_float(u & 0xffff0000u); }
__device__ __forceinline__ float bf1(unsigned short u) { return __uint_as_float((unsigned)u << 16); }
__device__ __forceinline__ float wave_sum(float v) {
#pragma unroll
    for (int o = 1; o < 64; o <<= 1) v += __shfl_xor(v, o);
    return v;
}
__device__ __forceinline__ float wave_max(float v) {
#pragma unroll
    for (int o = 1; o < 64; o <<= 1) v = fmaxf(v, __shfl_xor(v, o));
    return v;
}
__device__ __forceinline__ float siluf(float x) { return x * __builtin_amdgcn_rcpf(1.f + __expf(-x)); }
__device__ __forceinline__ float sigmoidf_(float x) { return __builtin_amdgcn_rcpf(1.f + __expf(-x)); }
__device__ __forceinline__ int crow(int reg, int h) { return (reg & 3) + 8 * (reg >> 2) + 4 * h; }
__device__ __forceinline__ int pi32(int r) { return (r & ~12) | ((r & 4) << 1) | ((r & 8) >> 1); }
#define MFMA32(a, b, c) __builtin_amdgcn_mfma_f32_32x32x16_bf16((a), (b), (c), 0, 0, 0)
__device__ __forceinline__ bf16x8 pack8(const f32x16& x, int s) {
    u32x4 p;
    p.x = cvtpk(x[8 * s + 0], x[8 * s + 1]); p.y = cvtpk(x[8 * s + 2], x[8 * s + 3]);
    p.z = cvtpk(x[8 * s + 4], x[8 * s + 5]); p.w = cvtpk(x[8 * s + 6], x[8 * s + 7]);
    return __builtin_bit_cast(bf16x8, p);
}
__device__ __forceinline__ void unpack8(u32x4 w, float* f) {
    f[0] = bflo(w.x); f[1] = bfhi(w.x); f[2] = bflo(w.y); f[3] = bfhi(w.y); f[4] = bflo(w.z); f[5] = bfhi(w.z); f[6] = bflo(w.w); f[7] = bfhi(w.w);
}

namespace pg8 {
constexpr int BM = 256, BK = 64, HALF = 128, HTB = HALF * BK * 2, STAGE_BYTES = 8 * HTB, NXCD = 8, WGM = 8;
__host__ __device__ __forceinline__ int lds_byte(int r, int c) { const int st = (r >> 4) * 2 + (c >> 5), rr = r & 15, cc = c & 31, ob = rr * 64 + cc * 2; return st * 1024 + (ob ^ (((ob >> 9) & 1) << 5)); }
__host__ __device__ __forceinline__ void stage_rc(int b, int& R, int& C) { const int st = b / 1024, sb = b % 1024, swz = sb ^ (((sb >> 9) & 1) << 5); R = (st >> 1) * 16 + swz / 64; C = (st & 1) * 32 + (swz % 64) / 2; }
__host__ __device__ __forceinline__ int perm32(int rho) { const int n = rho >> 4, i = rho & 15; return 8 * (i >> 2) + 4 * n + (i & 3); }

struct Unit { int pm, pn; };
struct Gemm { const bf16_t* A; const bf16_t* Bt; int M, N, K, lda; };

struct StaticOrder {
    int nM, nN, nwg, G, c;
    __device__ void init(int M, int N, int G_, int c_) { nM = M / BM; nN = N / BM; nwg = nM * nN; G = G_; c = c_; }
    __device__ bool next(int i, Unit& u) const {
        const long L = (long)i * G + c; if (L >= nwg) return false;
        int wgid = (int)L; { const int q = nwg / NXCD, r = nwg % NXCD, xcd = wgid % NXCD, off = wgid / NXCD; wgid = (xcd < r ? xcd * (q + 1) : r * (q + 1) + (xcd - r) * q) + off; }
        const int nig = WGM * nN, gid = wgid / nig, fm = gid * WGM, gsz = (nM - fm) < WGM ? (nM - fm) : WGM;
        u.pm = fm + ((wgid % nig) % gsz); u.pn = (wgid % nig) / gsz; return true;
    }
};

struct EpiBf16S {
    bf16_t* O; int ldc; const float* rs; int ncols;
    __device__ __forceinline__ void operator()(const f32x4 (&acc)[2][2][4][2], const Unit& u, int wr, int wc, int fr, int fq) const {
        const int row0 = u.pm * BM + wr * 64 + fr, col0 = u.pn * BM + wc * 32 + 8 * fq;
#pragma unroll
        for (int ai = 0; ai < 2; ++ai)
#pragma unroll
            for (int m = 0; m < 4; ++m) {
                const int row = row0 + ai * HALF + m * 16; const float s = rs ? rs[row] : 1.f;
#pragma unroll
                for (int bj = 0; bj < 2; ++bj) { const int col = col0 + bj * HALF;
                    if (col < ncols) { const f32x4 v0 = acc[ai][bj][m][0] * s, v1 = acc[ai][bj][m][1] * s; u32x4 w;
                        w.x = cvtpk(v0[0], v0[1]); w.y = cvtpk(v0[2], v0[3]); w.z = cvtpk(v1[0], v1[1]); w.w = cvtpk(v1[2], v1[3]);
                        *(u32x4*)(O + (size_t)row * ldc + col) = w; } }
            }
    }
};
struct EpiResid1 {
    bf16_t* XB; float* ss;
    __device__ __forceinline__ void operator()(const f32x4 (&acc)[2][2][4][2], const Unit& u, int wr, int wc, int fr, int fq) const {
        const int row0 = u.pm * BM + wr * 64 + fr, col0 = u.pn * BM + wc * 32 + 8 * fq;
#pragma unroll
        for (int ai = 0; ai < 2; ++ai)
#pragma unroll
            for (int m = 0; m < 4; ++m) {
                const int row = row0 + ai * HALF + m * 16; float s = 0.f;
#pragma unroll
                for (int bj = 0; bj < 2; ++bj) { const size_t o = (size_t)row * DM + col0 + bj * HALF;
                    float f[8]; unpack8(*(const u32x4*)(XB + o), f);
                    const f32x4 v0 = acc[ai][bj][m][0] + (f32x4){f[0], f[1], f[2], f[3]}, v1 = acc[ai][bj][m][1] + (f32x4){f[4], f[5], f[6], f[7]};
                    u32x4 w; w.x = cvtpk(v0[0], v0[1]); w.y = cvtpk(v0[2], v0[3]); w.z = cvtpk(v1[0], v1[1]); w.w = cvtpk(v1[2], v1[3]);
                    *(u32x4*)(XB + o) = w;
                    s += v0[0] * v0[0] + v0[1] * v0[1] + v0[2] * v0[2] + v0[3] * v0[3] + v1[0] * v1[0] + v1[1] * v1[1] + v1[2] * v1[2] + v1[3] * v1[3]; }
                s += __shfl_xor(s, 16); s += __shfl_xor(s, 32);
                if (fq == 0) atomicAdd(ss + row, s);
            }
    }
};
struct EpiSwiGLU {
    bf16_t* ACT; const float* ss;
    __device__ __forceinline__ void operator()(const f32x4 (&acc)[2][2][4][2], const Unit& u, int wr, int wc, int fr, int fq) const {
        const int row0 = u.pm * BM + wr * 64 + fr, col0 = u.pn * HALF + wc * 32 + 8 * fq;
#pragma unroll
        for (int ai = 0; ai < 2; ++ai)
#pragma unroll
            for (int m = 0; m < 4; ++m) {
                const int row = row0 + ai * HALF + m * 16; const float rs = rsqrtf(ss[row] * (1.f / DM) + EPS);
                float a[8];
#pragma unroll
                for (int n = 0; n < 2; ++n)
#pragma unroll
                    for (int j = 0; j < 4; ++j) { const float g = acc[ai][0][m][n][j] * rs, up = acc[ai][1][m][n][j] * rs; a[4 * n + j] = siluf(g) * up; }
                u32x4 w; w.x = cvtpk(a[0], a[1]); w.y = cvtpk(a[2], a[3]); w.z = cvtpk(a[4], a[5]); w.w = cvtpk(a[6], a[7]);
                __builtin_nontemporal_store(w, (u32x4*)(ACT + (size_t)row * DFF + col0));
            }
    }
};
struct EpiAccum {
    float* O; const bf16_t* XB;
    __device__ __forceinline__ void operator()(const f32x4 (&acc)[2][2][4][2], const Unit& u, int wr, int wc, int fr, int fq) const {
        const int row0 = u.pm * BM + wr * 64 + fr, col0 = u.pn * BM + wc * 32 + 8 * fq;
#pragma unroll
        for (int ai = 0; ai < 2; ++ai)
#pragma unroll
            for (int m = 0; m < 4; ++m) {
                const int row = row0 + ai * HALF + m * 16;
#pragma unroll
                for (int bj = 0; bj < 2; ++bj) { const size_t o = (size_t)row * DM + col0 + bj * HALF;
                    float f[8]; unpack8(__builtin_nontemporal_load((const u32x4*)(XB + o)), f);
                    __builtin_nontemporal_store(acc[ai][bj][m][0] + (f32x4){f[0], f[1], f[2], f[3]}, (f32x4*)(O + o));
                    __builtin_nontemporal_store(acc[ai][bj][m][1] + (f32x4){f[4], f[5], f[6], f[7]}, (f32x4*)(O + o + 4)); }
            }
    }
};

template <class Epi>
__device__ __forceinline__ void gemm_phase(LAS unsigned char* lds, const Gemm g, const StaticOrder& S, const Epi& E) {
    const int tid = opaque_tid(), wid = __builtin_amdgcn_readfirstlane(tid >> 6), lane = tid & 63, wr = wid >> 2, wc = wid & 3, fr = lane & 15, fq = lane >> 4;
    const int K = g.K, nt = K / BK, lda = g.lda;
    unsigned voffA[2], voffB[2];
#pragma unroll
    for (int i = 0; i < 2; ++i) { int R, C; stage_rc(tid * 16 + i * 8192, R, C); const int Rb = (R & ~31) + perm32(R & 31);
        voffA[i] = (unsigned)(R * lda + C) * 2u; voffB[i] = (unsigned)(Rb * K + C) * 2u; }
    const size_t kstep = (size_t)(BK * 2);
    const size_t hstepA = (size_t)HALF * lda * 2, hstepB = (size_t)HALF * K * 2;
    const size_t tstepA = 2 * hstepA, tstepB = 2 * hstepB;
    const unsigned ldsw = (unsigned)wid * 1024u;
    const int aoff = lds_byte(wr * 64 + fr, fq * 8), boff = lds_byte(wc * 32 + fr, fq * 8);
#define PG8_SA(b, h) (((b) * 2 + (h)) * HTB)
#define PG8_SB(b, h) ((4 + (b) * 2 + (h)) * HTB)
#define PG8_STAGE(bufoff, gbase, voff) do { _Pragma("unroll") for (int _i = 0; _i < 2; ++_i) \
        __builtin_amdgcn_global_load_lds((const unsigned*)((const char*)(gbase) + (voff)[_i]), (LAS unsigned*)(lds + (bufoff) + ldsw + _i * 8192), 16, 0, 0); } while (0)
#define PG8_LDA(dst, b, h) do { _Pragma("unroll") for (int m = 0; m < 4; ++m) _Pragma("unroll") for (int k = 0; k < 2; ++k) dst[m][k] = *(const LAS bf16x8*)(lds + PG8_SA(b, h) + aoff + m * 2048 + k * 1024); } while (0)
#define PG8_LDB(dst, b, h) do { _Pragma("unroll") for (int n = 0; n < 2; ++n) _Pragma("unroll") for (int k = 0; k < 2; ++k) dst[n][k] = *(const LAS bf16x8*)(lds + PG8_SB(b, h) + boff + n * 2048 + k * 1024); } while (0)
#define PG8_MMA(ai, bj, At, Bt) do { __builtin_amdgcn_s_setprio(1); _Pragma("unroll") for (int m = 0; m < 4; ++m) _Pragma("unroll") for (int n = 0; n < 2; ++n) _Pragma("unroll") for (int k = 0; k < 2; ++k) \
        acc[ai][bj][m][n] = __builtin_amdgcn_mfma_f32_16x16x32_bf16(Bt[n][k], At[m][k], acc[ai][bj][m][n], 0, 0, 0); __builtin_amdgcn_s_setprio(0); } while (0)
#define PG8_WAIT_V(n) asm volatile("s_waitcnt vmcnt(" #n ")" ::: "memory")
#define PG8_WAIT_L(n) asm volatile("s_waitcnt lgkmcnt(" #n ")" ::: "memory")
#define PG8_BAR __builtin_amdgcn_s_barrier()
#define PG8_SCHED __builtin_amdgcn_sched_barrier(0)
    Unit cur, nxt; int ui = 0;
    if (!S.next(0, cur)) return;
    f32x4 acc[2][2][4][2];
#pragma unroll
    for (int a = 0; a < 2; ++a)
#pragma unroll
        for (int b = 0; b < 2; ++b)
#pragma unroll
            for (int m = 0; m < 4; ++m)
#pragma unroll
                for (int n = 0; n < 2; ++n) acc[a][b][m][n] = (f32x4){0.f, 0.f, 0.f, 0.f};
    bf16x8 At[4][2], B0[2][2], B1[2][2];
    const char* cA = (const char*)g.A + (size_t)cur.pm * tstepA; const char* cB = (const char*)g.Bt + (size_t)cur.pn * tstepB;
    PG8_STAGE(PG8_SB(0, 0), cB, voffB); PG8_STAGE(PG8_SB(0, 1), cB + hstepB, voffB); PG8_STAGE(PG8_SA(0, 0), cA, voffA); PG8_STAGE(PG8_SA(0, 1), cA + hstepA, voffA);
    if (wr == 1) PG8_BAR;
    PG8_WAIT_V(2); PG8_BAR;
    PG8_STAGE(PG8_SB(1, 0), cB + kstep, voffB); PG8_STAGE(PG8_SA(1, 0), cA + kstep, voffA); PG8_STAGE(PG8_SB(1, 1), cB + hstepB + kstep, voffB);
    PG8_WAIT_V(6); PG8_BAR;
    for (;;) {
        const bool has_next = S.next(ui + 1, nxt);
        const char* nA = has_next ? (const char*)g.A + (size_t)nxt.pm * tstepA : cA; const char* nB = has_next ? (const char*)g.Bt + (size_t)nxt.pn * tstepB : cB;
        for (int t = 0; t < nt; t += 2) {
            const bool last = (t == nt - 2);
            const char* a1 = cA + (size_t)(t + 1) * kstep;
            const char* a2 = last ? nA : cA + (size_t)(t + 2) * kstep; const char* b2 = last ? nB : cB + (size_t)(t + 2) * kstep;
            const char* a3 = a2 + kstep; const char* b3 = b2 + kstep;
            PG8_LDB(B0, 0, 0); PG8_LDB(B1, 0, 1); PG8_SCHED; PG8_LDA(At, 0, 0); PG8_STAGE(PG8_SA(1, 1), a1 + hstepA, voffA);
            PG8_WAIT_V(8); PG8_WAIT_L(0); PG8_BAR; PG8_MMA(0, 0, At, B0); PG8_MMA(0, 1, At, B1); PG8_BAR; PG8_SCHED;
            PG8_LDA(At, 0, 1); PG8_STAGE(PG8_SB(0, 0), b2, voffB); PG8_STAGE(PG8_SB(0, 1), b2 + hstepB, voffB); PG8_STAGE(PG8_SA(0, 0), a2, voffA);
            PG8_WAIT_V(8); PG8_WAIT_L(0); PG8_BAR; PG8_MMA(1, 0, At, B0); PG8_MMA(1, 1, At, B1); PG8_BAR; PG8_SCHED;
            PG8_LDB(B0, 1, 0); PG8_LDB(B1, 1, 1); PG8_SCHED; PG8_LDA(At, 1, 0); PG8_STAGE(PG8_SA(0, 1), a2 + hstepA, voffA);
            PG8_WAIT_V(8); PG8_WAIT_L(0); PG8_BAR; PG8_MMA(0, 0, At, B0); PG8_MMA(0, 1, At, B1); PG8_BAR; PG8_SCHED;
            PG8_LDA(At, 1, 1); PG8_STAGE(PG8_SB(1, 0), b3, voffB); PG8_STAGE(PG8_SB(1, 1), b3 + hstepB, voffB); PG8_STAGE(PG8_SA(1, 0), a3, voffA);
            PG8_WAIT_V(8); PG8_WAIT_L(0); PG8_BAR; PG8_MMA(1, 0, At, B0); PG8_MMA(1, 1, At, B1); PG8_BAR; PG8_SCHED;
        }
        if (wr == 0) PG8_BAR;
        E(acc, cur, wr, wc, fr, fq);
        if (!has_next) break;
#pragma unroll
        for (int a = 0; a < 2; ++a)
#pragma unroll
            for (int b = 0; b < 2; ++b)
#pragma unroll
                for (int m = 0; m < 4; ++m)
#pragma unroll
                    for (int n = 0; n < 2; ++n) acc[a][b][m][n] = (f32x4){0.f, 0.f, 0.f, 0.f};
        cur = nxt; cA = nA; cB = nB; ++ui;
        if (wr == 1) PG8_BAR;
    }
    PG8_WAIT_V(0);
    PG8_BAR;
#undef PG8_SA
#undef PG8_SB
#undef PG8_STAGE
#undef PG8_LDA
#undef PG8_LDB
#undef PG8_MMA
#undef PG8_WAIT_V
#undef PG8_WAIT_L
#undef PG8_BAR
#undef PG8_SCHED
}
}

__device__ __forceinline__ void transpose_item(const float* W, int K, int N, bf16_t* WT, int k0, int n0, int orow0, const float* ksc, LAS float* scr, int lane) {
    const int c4 = lane & 15, kr = lane >> 4;
    f32x4 v[16];
#pragma unroll
    for (int i = 0; i < 16; ++i) v[i] = __builtin_nontemporal_load((const f32x4*)(W + (size_t)(k0 + 4 * i + kr) * N + n0 + 4 * c4));
#pragma unroll
    for (int i = 0; i < 16; ++i) { const int kk = 4 * i + kr; const float sc = ksc ? ksc[k0 + kk] : 1.f; LAS float* d = scr + kk * 65 + 4 * c4;
        d[0] = v[i][0] * sc; d[1] = v[i][1] * sc; d[2] = v[i][2] * sc; d[3] = v[i][3] * sc; }
    asm volatile("s_waitcnt lgkmcnt(0)" ::: "memory");
    const int c = lane & 7;
#pragma unroll
    for (int j = 0; j < 8; ++j) { const int n = (lane >> 3) + 8 * j; const LAS float* sp = scr + (8 * c) * 65 + n;
        u32x4 o; o.x = cvtpk(sp[0 * 65], sp[1 * 65]); o.y = cvtpk(sp[2 * 65], sp[3 * 65]); o.z = cvtpk(sp[4 * 65], sp[5 * 65]); o.w = cvtpk(sp[6 * 65], sp[7 * 65]);
        *(u32x4*)(WT + (size_t)(orow0 + n) * K + k0 + 8 * c) = o; }
    asm volatile("s_waitcnt lgkmcnt(0)" ::: "memory");
}
constexpr int I_IN = (DM / 64) * (DIN / 64), I_UQ = (QL / 64) * (MH * QKD / 64), I_UKV = (KVL / 64) * (2048 / 64), I_OUT = (DM / 64) * (DM / 64),
              I_GU = (DM / 64) * (2 * DFF / 64), I_DN = (DFF / 64) * (DM / 64);
constexpr int IT_EARLY = I_IN + I_UQ + I_UKV, IT_ALL = IT_EARLY + I_OUT + I_GU + I_DN;
__device__ __forceinline__ void convert_range(const Params& p, LAS unsigned char* lds, int lo, int hi, int gw, int NGW, int wave, int lane) {
    unsigned char* ws = p.ws;
    LAS float* scr = (LAS float*)(lds + wave * 16640);
    bf16_t* Wt_in = (bf16_t*)(ws + WS_WIN); bf16_t* Wt_gu = (bf16_t*)(ws + WS_WGU); bf16_t* Wt_dn = (bf16_t*)(ws + WS_WDN);
    bf16_t* Wt_out = (bf16_t*)(ws + WS_WOUT); bf16_t* Wt_uq = (bf16_t*)(ws + WS_WUQ); bf16_t* Wt_ukv = (bf16_t*)(ws + WS_WUKV);
    for (int it = lo + gw; it < hi; it += NGW) {
        int r = it; const float* W; const float* ksc; bf16_t* WT; int K, N, nb; bool gu = false;
        if (r < I_IN) { W = p.w_in; K = DM; N = DIN; WT = Wt_in; ksc = p.attn_norm_w; }
        else if ((r -= I_IN) < I_UQ) { W = p.w_uq; K = QL; N = MH * QKD; WT = Wt_uq; ksc = p.q_norm_w; }
        else if ((r -= I_UQ) < I_UKV) { W = p.w_ukv; K = KVL; N = 2048; WT = Wt_ukv; ksc = p.kv_norm_w; }
        else if ((r -= I_UKV) < I_OUT) { W = p.w_out; K = DM; N = DM; WT = Wt_out; ksc = nullptr; }
        else if ((r -= I_OUT) < I_GU) { W = p.w_gu; K = DM; N = 2 * DFF; WT = Wt_gu; ksc = p.ffn_norm_w; gu = true; }
        else { r -= I_GU; W = p.w_dn; K = DFF; N = DM; WT = Wt_dn; ksc = nullptr; }
        nb = N / 64; const int n0 = 64 * (r % nb), k0 = 64 * (r / nb);
        const int orow = !gu ? n0 : ((n0 < DFF) ? (256 * (n0 / 128) + (n0 % 128)) : (256 * ((n0 - DFF) / 128) + 128 + ((n0 - DFF) % 128)));
        transpose_item(W, K, N, WT, k0, n0, orow, ksc, scr, lane);
    }
}

__device__ __forceinline__ void p0_prep(const Params& p, LAS unsigned char* lds) {
    const int tid = opaque_tid(), lane = tid & 63, wave = tid >> 6;
    const int G = gridDim.x, gw = blockIdx.x * 8 + wave, NGW = G * 8;
    unsigned char* ws = p.ws;
    bf16_t* Wt_in = (bf16_t*)(ws + WS_WIN);
    convert_range(p, lds, 0, IT_EARLY, gw, NGW, wave, lane);
    { const int gt = blockIdx.x * 512 + tid, NT = G * 512; u32x4* z = (u32x4*)(Wt_in + (size_t)DIN * DM); const int n16 = (DINP - DIN) * DM * 2 / 16;
      for (int i = gt; i < n16; i += NT) z[i] = (u32x4){0u, 0u, 0u, 0u};
      float* ss2 = (float*)(ws + WS_SS2); for (int i = gt; i < T; i += NT) ss2[i] = 0.f;
      float* lbT = (float*)(ws + WS_LB); for (int i = gt; i < HGW; i += NT) lbT[i] = 1.f / (1.f + __expf(p.hgrn_lb[HGW + i] - p.hgrn_lb[i]));
      float* cosT = (float*)(ws + WS_ROPE); float* sinT = cosT + (size_t)T * 32;
      for (int i = gt; i < T * 32; i += NT) { const int t = i >> 5, f = i & 31;
          const float invf = (float)exp(-(double)f * (9.210340371976184 / 32.0));
          const float ang = (float)p.pos[t] * invf;
          const double xd = (double)ang; const double kq = rint(xd * 0.6366197723675814); const double rr = xd - kq * 1.5707963267948966;
          const double r2 = rr * rr;
          const double sn = rr * (1.0 + r2 * (-1.0 / 6 + r2 * (1.0 / 120 + r2 * (-1.0 / 5040 + r2 * (1.0 / 362880 + r2 * (-1.0 / 39916800))))));
          const double cs = 1.0 + r2 * (-0.5 + r2 * (1.0 / 24 + r2 * (-1.0 / 720 + r2 * (1.0 / 40320 + r2 * (-1.0 / 3628800 + r2 * (1.0 / 479001600))))));
          const int q = ((int)kq) & 3; double c, s;
          if (q == 0) { c = cs; s = sn; } else if (q == 1) { c = -sn; s = cs; } else if (q == 2) { c = -cs; s = -sn; } else { c = sn; s = -cs; }
          cosT[i] = (float)c; sinT[i] = (float)s; }
    }
    bf16_t* xb = (bf16_t*)(ws + WS_XB); float* rs1 = (float*)(ws + WS_RS1);
    for (int m = gw; m < T; m += 2 * NGW) {
        const int m2 = (m + NGW < T) ? m + NGW : m;
        const f32x4* xr = (const f32x4*)(p.x + (size_t)m * DM) + 2 * lane; const f32x4* xr2 = (const f32x4*)(p.x + (size_t)m2 * DM) + 2 * lane; f32x4 v[8], v2[8]; float s = 0.f, s2 = 0.f;
#pragma unroll
        for (int j = 0; j < 4; ++j) { v[2 * j] = __builtin_nontemporal_load(xr + 128 * j); v[2 * j + 1] = __builtin_nontemporal_load(xr + 128 * j + 1);
            v2[2 * j] = __builtin_nontemporal_load(xr2 + 128 * j); v2[2 * j + 1] = __builtin_nontemporal_load(xr2 + 128 * j + 1); }
#pragma unroll
        for (int j = 0; j < 8; ++j) { s += v[j][0] * v[j][0] + v[j][1] * v[j][1] + v[j][2] * v[j][2] + v[j][3] * v[j][3]; s2 += v2[j][0] * v2[j][0] + v2[j][1] * v2[j][1] + v2[j][2] * v2[j][2] + v2[j][3] * v2[j][3]; }
        s = wave_sum(s); s2 = wave_sum(s2);
        u32x4* o = (u32x4*)(xb + (size_t)m * DM) + lane; u32x4* o2 = (u32x4*)(xb + (size_t)m2 * DM) + lane;
#pragma unroll
        for (int j = 0; j < 4; ++j) { u32x4 w; w.x = cvtpk(v[2 * j][0], v[2 * j][1]); w.y = cvtpk(v[2 * j][2], v[2 * j][3]); w.z = cvtpk(v[2 * j + 1][0], v[2 * j + 1][1]); w.w = cvtpk(v[2 * j + 1][2], v[2 * j + 1][3]); o[64 * j] = w;
            w.x = cvtpk(v2[2 * j][0], v2[2 * j][1]); w.y = cvtpk(v2[2 * j][2], v2[2 * j][3]); w.z = cvtpk(v2[2 * j + 1][0], v2[2 * j + 1][1]); w.w = cvtpk(v2[2 * j + 1][2], v2[2 * j + 1][3]); o2[64 * j] = w; }
        if (lane == 0) { rs1[m] = rsqrtf(s * (1.f / DM) + EPS); rs1[m2] = rsqrtf(s2 * (1.f / DM) + EPS); }
    }
}

constexpr int H_LF = 0;
constexpr int H_SEG = 33024;
constexpr int H_VT = H_SEG + 2048;
constexpr int H_KT = H_VT + 18432;
constexpr int H_SS = H_KT + 18432;
static_assert(H_SS + 2048 <= 131072, "hgrn lds");

__device__ __forceinline__ void hgrn_pass_a(const Params& p, LAS unsigned char* lds, int u) {
    const int tid = opaque_tid(), lane = tid & 63, wave = __builtin_amdgcn_readfirstlane(tid >> 6), r = lane & 31, hi = lane >> 5;
    const int bh = u >> 7, c = u & 127, b = bh >> 3, h = bh & 7, tok0 = b * SEQ + c * CHUNK;
    bf16_t* proj = (bf16_t*)(p.ws + WS_PROJ);
    bf16_t* states = (bf16_t*)((unsigned char*)p.out + OUT_ST); float* dec = (float*)(p.ws + WS_DEC); float* emid = (float*)(p.ws + WS_EMID);
    const float* lbT = (const float*)(p.ws + WS_LB);
    LAS float* LF = (LAS float*)(lds + H_LF); LAS float* SEG = (LAS float*)(lds + H_SEG);
    LAS unsigned short* VT = (LAS unsigned short*)(lds + H_VT); LAS unsigned short* KT = (LAS unsigned short*)(lds + H_KT);
    const int ch = (tid & 3) + 4 * (tid >> 8), t = (tid >> 2) & 63, d0 = 16 * ch;
    bf16_t* rowp = proj + (size_t)(tok0 + t) * DIN + h * 128 + d0;
    const u32x4 i0 = *(const u32x4*)(rowp + 2048), i1 = *(const u32x4*)(rowp + 2048 + 8);
    const u32x4 q0 = *(const u32x4*)(rowp), q1 = *(const u32x4*)(rowp + 8);
    const u32x4 f0 = *(const u32x4*)(rowp + 1024), f1 = *(const u32x4*)(rowp + 1024 + 8);
    bf16_t* tile = proj + (size_t)tok0 * DIN + h * 128;
    float kf[16];
    { float f[16]; unpack8(f0, f); unpack8(f1, f + 8);
#pragma unroll
      for (int j = 0; j < 16; ++j) { const float lb = lbT[h * 128 + d0 + j]; const float fg = lb + (1.f - lb) * sigmoidf_(f[j]); kf[j] = 1.f - fg; LF[t * 129 + d0 + j] = __logf(fg); } }
    asm volatile("s_waitcnt vmcnt(0)" ::: "memory");
    __syncthreads();
    { const int d = tid & 127, seg = tid >> 7; float run = 0.f;
#pragma unroll
      for (int j = 0; j < 16; ++j) { run += LF[(16 * seg + j) * 129 + d]; LF[(16 * seg + j) * 129 + d] = run; }
      SEG[seg * 128 + d] = run;
      __syncthreads();
      float off = 0.f;
      for (int s2 = 0; s2 < seg; ++s2) off += SEG[s2 * 128 + d];
      if (seg > 0) {
#pragma unroll
          for (int j = 0; j < 16; ++j) LF[(16 * seg + j) * 129 + d] += off; } }
    __syncthreads();
    { float q[16]; unpack8(q0, q); unpack8(q1, q + 8);
      const unsigned iv[8] = {i0.x, i0.y, i0.z, i0.w, i1.x, i1.y, i1.z, i1.w};
      float qt[16], kp[16];
#pragma unroll
      for (int j = 0; j < 16; ++j) { const int dl = d0 + j; const float bt = LF[t * 129 + dl], bm = LF[31 * 129 + dl];
          qt[j] = siluf(q[j]) * __expf(bt - bm); kp[j] = kf[j] * __expf(bm - bt);
          KT[dl * 72 + t] = (unsigned short)(cvtpk(kp[j], 0.f) & 0xffffu);
          VT[dl * 72 + t] = (unsigned short)((j & 1) ? (iv[j >> 1] >> 16) : (iv[j >> 1] & 0xffffu)); }
#pragma unroll
      for (int k = 0; k < 2; ++k) { u32x4 w;
          w.x = cvtpk(qt[8 * k], qt[8 * k + 1]); w.y = cvtpk(qt[8 * k + 2], qt[8 * k + 3]); w.z = cvtpk(qt[8 * k + 4], qt[8 * k + 5]); w.w = cvtpk(qt[8 * k + 6], qt[8 * k + 7]);
          { const int n = (((t >> 5) * 8 + ch) * 2 + k) * 32 + (t & 31); *(u32x4*)(tile + (size_t)(n >> 4) * DIN + (n & 15) * 8) = w; }
          w.x = cvtpk(kp[8 * k], kp[8 * k + 1]); w.y = cvtpk(kp[8 * k + 2], kp[8 * k + 3]); w.z = cvtpk(kp[8 * k + 4], kp[8 * k + 5]); w.w = cvtpk(kp[8 * k + 6], kp[8 * k + 7]);
          { const int n = (((t >> 5) * 8 + ch) * 2 + k) * 32 + pi32(t & 31); *(u32x4*)(tile + (size_t)(n >> 4) * DIN + 1024 + (n & 15) * 8) = w; } } }
    if (tid < 128) { dec[(size_t)u * 128 + tid] = __expf(LF[63 * 129 + tid]); emid[(size_t)u * 128 + tid] = __expf(LF[31 * 129 + tid]); }
    __syncthreads();
    { const int vb = wave >> 1;
#pragma unroll
      for (int q = 0; q < 2; ++q) { const int db = 2 * (wave & 1) + q; f32x16 acc;
#pragma unroll
          for (int i = 0; i < 16; ++i) acc[i] = 0.f;
#pragma unroll
          for (int ks = 0; ks < 4; ++ks) { const bf16x8 a = *(const LAS bf16x8*)(VT + (32 * vb + r) * 72 + 16 * ks + 8 * hi);
              const bf16x8 bb = *(const LAS bf16x8*)(KT + (32 * db + r) * 72 + 16 * ks + 8 * hi); acc = MFMA32(a, bb, acc); }
          const float sc = __expf(LF[63 * 129 + 32 * db + r] - LF[31 * 129 + 32 * db + r]);
          const int dd = 32 * db + r; bf16_t* o = states + (size_t)u * 16384 + ((((vb * 8 + (dd >> 4)) * 2 + ((dd >> 3) & 1)) * 32) * 8) + (dd & 7);
#pragma unroll
          for (int i = 0; i < 16; ++i) o[crow(i, hi) * 8] = (bf16_t)(cvtpk(acc[i] * sc, 0.f) & 0xffffu); }
#pragma unroll
      for (int i = 0; i < 2; ++i) { const int q = tid + 512 * i, v = q >> 3, s8 = q & 7, n = (((v >> 5) * 4 + (s8 >> 1)) * 2 + (s8 & 1)) * 32 + (v & 31);
          const u32x4 w = *(const LAS u32x4*)(VT + v * 72 + 8 * s8);
          *(u32x4*)(tile + (size_t)(n >> 4) * DIN + 2048 + (n & 15) * 8) = w; } }
    __syncthreads();
}

__device__ __forceinline__ void hgrn_pass_c(const Params& p, LAS unsigned char* wl  , int u) {
    const int tid = opaque_tid(), lane = tid & 63, r = lane & 31, hi = lane >> 5;
    const int bh = u >> 7, c = u & 127, b = bh >> 3, h = bh & 7, tok0 = b * SEQ + c * CHUNK;
    const bf16_t* proj = (const bf16_t*)(p.ws + WS_PROJ);
    const bf16_t* states = (const bf16_t*)((unsigned char*)p.out + OUT_ST); bf16_t* mix = (bf16_t*)(p.ws + WS_MIX);
    const __amdgpu_buffer_rsrc_t rp = __builtin_amdgcn_make_buffer_rsrc((void*)(p.ws + WS_PROJ), 0, 0x7fffffff, 0x00020000);
    const __amdgpu_buffer_rsrc_t rst = __builtin_amdgcn_make_buffer_rsrc((void*)p.out, 0, 0x7fffffff, 0x00020000);
    const unsigned loff = (unsigned)((lane >> 4) * DIN + (lane & 15) * 8) * 2u;
    const int uoff = (tok0 * DIN + h * 128) * 2;
#define HG_CHUNK(colbase, n) __builtin_bit_cast(bf16x8, __builtin_amdgcn_raw_buffer_load_b128(rp, loff, uoff + ((((n) - lane) >> 4) * (DIN * 2) + (colbase) * 2), 2))
#pragma unroll 1
    for (int tb = 0; tb < 2; ++tb) {
        bf16x8 bq[8], kf0[8], kf1[8], vt[4][4]; bf16x8 pb[4];
#pragma unroll
        for (int ks = 0; ks < 8; ++ks) { bq[ks] = HG_CHUNK(0, (tb * 8 + ks) * 64 + lane); kf0[ks] = HG_CHUNK(1024, ks * 64 + lane); }
#pragma unroll
        for (int vb = 0; vb < 4; ++vb)
#pragma unroll
            for (int kk = 0; kk < 2; ++kk) vt[vb][kk] = HG_CHUNK(2048, (vb * 4 + kk) * 64 + lane);
        if (tb == 1) {
#pragma unroll
            for (int ks = 0; ks < 8; ++ks) kf1[ks] = HG_CHUNK(1024, (8 + ks) * 64 + lane);
#pragma unroll
            for (int vb = 0; vb < 4; ++vb)
#pragma unroll
                for (int kk = 2; kk < 4; ++kk) vt[vb][kk] = HG_CHUNK(2048, (vb * 4 + kk) * 64 + lane);
        } else {
#pragma unroll
            for (int ks = 0; ks < 8; ++ks) kf1[ks] = kf0[ks];
#pragma unroll
            for (int vb = 0; vb < 4; ++vb) { vt[vb][2] = vt[vb][0]; vt[vb][3] = vt[vb][1]; }
        }
        __builtin_amdgcn_sched_barrier(0);
        {   f32x16 sc;
#pragma unroll
            for (int i = 0; i < 16; ++i) sc[i] = 0.f;
#pragma unroll
            for (int ks = 0; ks < 8; ++ks) sc = MFMA32(kf0[ks], bq[ks], sc);
            if (tb == 0) {
#pragma unroll
                for (int i = 0; i < 16; ++i) if (pi32(crow(i, hi)) > r) sc[i] = 0.f; }
            pb[0] = pack8(sc, 0); pb[1] = pack8(sc, 1);
#pragma unroll
            for (int i = 0; i < 16; ++i) sc[i] = 0.f;
#pragma unroll
            for (int ks = 0; ks < 8; ++ks) sc = MFMA32(kf1[ks], bq[ks], sc);
#pragma unroll
            for (int i = 0; i < 16; ++i) if (tb == 0 || pi32(crow(i, hi)) > r) sc[i] = 0.f;
            pb[2] = pack8(sc, 0); pb[3] = pack8(sc, 1);
        }
        f32x16 o[4];
#pragma unroll
        for (int vb = 0; vb < 4; ++vb) {
#pragma unroll
            for (int i = 0; i < 16; ++i) o[vb][i] = 0.f;
#pragma unroll
            for (int kk = 0; kk < 4; ++kk) o[vb] = MFMA32(vt[vb][kk], pb[kk], o[vb]);
        }
        if (c > 0) {
#pragma unroll
            for (int vh = 0; vh < 2; ++vh) { bf16x8 st[2][8];
#pragma unroll
                for (int v2 = 0; v2 < 2; ++v2) { const int so = (u - 1) * 32768 + (2 * vh + v2) * 8192;
#pragma unroll
                    for (int ks = 0; ks < 8; ++ks) st[v2][ks] = __builtin_bit_cast(bf16x8, __builtin_amdgcn_raw_buffer_load_b128(rst, (unsigned)lane * 16u, so + ks * 1024, 2)); }
                __builtin_amdgcn_sched_barrier(0);
#pragma unroll
                for (int v2 = 0; v2 < 2; ++v2)
#pragma unroll
                    for (int ks = 0; ks < 8; ++ks) o[2 * vh + v2] = MFMA32(st[v2][ks], bq[ks], o[2 * vh + v2]); }
        }
        float ss = 0.f;
#pragma unroll
        for (int vb = 0; vb < 4; ++vb)
#pragma unroll
            for (int i = 0; i < 16; ++i) ss += o[vb][i] * o[vb][i];
        ss += __shfl_xor(ss, 32);
        const float rs = rsqrtf(ss * (1.f / HDV) + EPS);
        { const bf16_t* gbase = proj + (size_t)(tok0 + 32 * tb) * DIN + 3072 + h * 128;
#pragma unroll
          for (int i = 0; i < 8; ++i) { const int row = 4 * i + (lane >> 4), c16 = lane & 15; const u32x4 gv = __builtin_nontemporal_load((const u32x4*)(gbase + (size_t)row * DIN + c16 * 8));
              *(LAS u32x2*)(wl + row * 264 + c16 * 16) = (u32x2){gv.x, gv.y}; *(LAS u32x2*)(wl + row * 264 + c16 * 16 + 8) = (u32x2){gv.z, gv.w}; } }
#pragma unroll
        for (int vb = 0; vb < 4; ++vb)
#pragma unroll
            for (int g = 0; g < 4; ++g) { const int v = 32 * vb + 8 * g + 4 * hi; LAS u32x2* cell = (LAS u32x2*)(wl + r * 264 + v * 2);
                const u32x2 gw = *cell; const f32x4 nw = *(const f32x4*)(p.hgrn_norm_w + v);
                const float o0 = o[vb][4 * g] * rs * nw[0] * siluf(bflo(gw.x)), o1 = o[vb][4 * g + 1] * rs * nw[1] * siluf(bfhi(gw.x));
                const float o2 = o[vb][4 * g + 2] * rs * nw[2] * siluf(bflo(gw.y)), o3 = o[vb][4 * g + 3] * rs * nw[3] * siluf(bfhi(gw.y));
                u32x2 w; w.x = cvtpk(o0, o1); w.y = cvtpk(o2, o3); *cell = w; }
        { bf16_t* obase = mix + (size_t)(tok0 + 32 * tb) * DM + h * 128;
#pragma unroll
          for (int i = 0; i < 8; ++i) { const int row = 4 * i + (lane >> 4), c16 = lane & 15;
              const u32x2 lo = *(const LAS u32x2*)(wl + row * 264 + c16 * 16), hi2 = *(const LAS u32x2*)(wl + row * 264 + c16 * 16 + 8);
              *(u32x4*)(obase + (size_t)row * DM + c16 * 8) = (u32x4){lo.x, lo.y, hi2.x, hi2.y}; } }
    }
#undef HG_CHUNK
}

__device__ __forceinline__ void hgrn_scan(const Params& p) {
    bf16_t* states = (bf16_t*)((unsigned char*)p.out + OUT_ST); const float* dec = (const float*)(p.ws + WS_DEC); const float* emid = (const float*)(p.ws + WS_EMID);
    const int gt = blockIdx.x * 512 + opaque_tid(), NT = gridDim.x * 512;
    for (int pr = gt; pr < 16 * 8192; pr += NT) { const int bh = pr >> 13, e = (pr & 8191) * 2, d = ((e >> 9) & 7) * 16 + ((e >> 8) & 1) * 8 + (e & 7);
        float s0 = 0.f, s1 = 0.f;
        for (int c0 = 0; c0 < NCH; c0 += 16) {
            unsigned L[16]; f32x2_t dd[16], em[16];
#pragma unroll
            for (int j = 0; j < 16; ++j) { const size_t u = (size_t)bh * NCH + c0 + j; const size_t un = (u + 1 < 2048) ? u + 1 : u;
                L[j] = *(const unsigned*)(states + u * 16384 + e); dd[j] = *(const f32x2_t*)(dec + u * 128 + d); em[j] = *(const f32x2_t*)(emid + un * 128 + d); }
#pragma unroll
            for (int j = 0; j < 16; ++j) { s0 = dd[j][0] * s0 + bflo(L[j]); s1 = dd[j][1] * s1 + bfhi(L[j]); L[j] = cvtpk(s0 * em[j][0], s1 * em[j][1]); }
#pragma unroll
            for (int j = 0; j < 16; ++j) { const size_t u = (size_t)bh * NCH + c0 + j; *(unsigned*)(states + u * 16384 + e) = L[j]; }
        } }
}

constexpr int P3_VL = 0;
__device__ __forceinline__ float red8(float v) { v += __shfl_xor(v, 1); v += __shfl_xor(v, 2); v += __shfl_xor(v, 4); return v; }
__device__ __forceinline__ void p3_tile(const Params& p, LAS unsigned char* lds, int tile) {
    const int tid = opaque_tid();
    const int g = tid >> 3, j = tid & 7;
    const int tok0 = tile * 64, b = tok0 / SEQ, s0 = tok0 % SEQ, t = tok0 + g;
    const bf16_t* proj = (const bf16_t*)(p.ws + WS_PROJ); const bf16_t* kvraw = (const bf16_t*)(p.ws + WS_MIX);
    bf16_t* Kn = (bf16_t*)(p.ws + WS_KN); bf16_t* Vt = (bf16_t*)(p.ws + WS_VT);
    const float* cosT = (const float*)(p.ws + WS_ROPE); const float* sinT = cosT + (size_t)T * 32;
    LAS unsigned short* VL = (LAS unsigned short*)(lds + P3_VL);
    float rsq, rskv, skr, kr[8];
    { const bf16_t* rowp = proj + (size_t)t * DIN; float sq = 0.f, skv = 0.f;
#pragma unroll 2
      for (int i = 0; i < 8; ++i) { float f[8]; unpack8(__builtin_nontemporal_load((const u32x4*)(rowp + 4096 + 8 * (j + 8 * i))), f);
#pragma unroll
          for (int e = 0; e < 8; ++e) sq += f[e] * f[e];
          unpack8(__builtin_nontemporal_load((const u32x4*)(rowp + 4608 + 8 * (j + 8 * i))), f);
#pragma unroll
          for (int e = 0; e < 8; ++e) skv += f[e] * f[e]; }
      unpack8(__builtin_nontemporal_load((const u32x4*)(rowp + 5120 + 8 * j)), kr); skr = 0.f;
#pragma unroll
      for (int e = 0; e < 8; ++e) skr += kr[e] * kr[e];
      rsq = rsqrtf(red8(sq) * (1.f / QL) + EPS); rskv = rsqrtf(red8(skv) * (1.f / KVL) + EPS); skr = red8(skr); }
    if (j == 0) ((float*)(p.ws + WS_RS1))[t] = rsq;
    float cs[8], sn[8];
    { const f32x4 c0 = *(const f32x4*)(cosT + (size_t)t * 32 + 8 * (j & 3)), c1 = *(const f32x4*)(cosT + (size_t)t * 32 + 8 * (j & 3) + 4);
      const f32x4 s0v = *(const f32x4*)(sinT + (size_t)t * 32 + 8 * (j & 3)), s1v = *(const f32x4*)(sinT + (size_t)t * 32 + 8 * (j & 3) + 4);
      const float sg = (j < 4) ? -1.f : 1.f;
#pragma unroll
      for (int e = 0; e < 4; ++e) { cs[e] = c0[e]; cs[4 + e] = c1[e]; sn[e] = sg * s0v[e]; sn[4 + e] = sg * s1v[e]; } }
    u32x4 nk0 = __builtin_nontemporal_load((const u32x4*)(kvraw + (size_t)t * 2048 + 8 * j)), nk1 = __builtin_nontemporal_load((const u32x4*)(kvraw + (size_t)t * 2048 + 64 + 8 * j));
#pragma unroll 1
    for (int hh = 0; hh < 8; ++hh) {
        { const bf16_t* kp = kvraw + (size_t)t * 2048 + hh * 256; bf16_t* ko = Kn + ((size_t)(b * 8 + hh) * SEQ + s0 + g) * QKD; float f0[8], f1[8];
          const u32x4 c0r = nk0, c1r = nk1;
          if (hh < 7) { nk0 = __builtin_nontemporal_load((const u32x4*)(kp + 256 + 8 * j)); nk1 = __builtin_nontemporal_load((const u32x4*)(kp + 256 + 64 + 8 * j)); }
          unpack8(c0r, f0); unpack8(c1r, f1);
          float ss = 0.f;
#pragma unroll
          for (int e = 0; e < 8; ++e) ss += f0[e] * f0[e] + f1[e] * f1[e];
          ss = red8(ss) * rskv * rskv + skr;
          const float rk = rsqrtf(ss * (1.f / QKD) + EPS), rr = rskv * rk;
          const f32x4 wa = *(const f32x4*)(p.kh_w + 8 * j), wb = *(const f32x4*)(p.kh_w + 8 * j + 4), wc = *(const f32x4*)(p.kh_w + 64 + 8 * j), wd = *(const f32x4*)(p.kh_w + 64 + 8 * j + 4);
          const f32x4 we = *(const f32x4*)(p.kh_w + 128 + 8 * j), wf = *(const f32x4*)(p.kh_w + 128 + 8 * j + 4);
          u32x4 w; w.x = cvtpk(f0[0] * rr * wa[0], f0[1] * rr * wa[1]); w.y = cvtpk(f0[2] * rr * wa[2], f0[3] * rr * wa[3]);
          w.z = cvtpk(f0[4] * rr * wb[0], f0[5] * rr * wb[1]); w.w = cvtpk(f0[6] * rr * wb[2], f0[7] * rr * wb[3]); *(u32x4*)(ko + 8 * j) = w;
          w.x = cvtpk(f1[0] * rr * wc[0], f1[1] * rr * wc[1]); w.y = cvtpk(f1[2] * rr * wc[2], f1[3] * rr * wc[3]);
          w.z = cvtpk(f1[4] * rr * wd[0], f1[5] * rr * wd[1]); w.w = cvtpk(f1[6] * rr * wd[2], f1[7] * rr * wd[3]); *(u32x4*)(ko + 64 + 8 * j) = w;
          float a[8], o[8];
#pragma unroll
          for (int e = 0; e < 4; ++e) { a[e] = kr[e] * rk * we[e]; a[4 + e] = kr[4 + e] * rk * wf[e]; }
#pragma unroll
          for (int e = 0; e < 8; ++e) { const float pa = __shfl_xor(a[e], 4); o[e] = a[e] * cs[e] + pa * sn[e]; }
          w.x = cvtpk(o[0], o[1]); w.y = cvtpk(o[2], o[3]); w.z = cvtpk(o[4], o[5]); w.w = cvtpk(o[6], o[7]); *(u32x4*)(ko + 128 + 8 * j) = w; }
    }
#pragma unroll 1
    for (int hh = 0; hh < 8; hh += 4) {
        { const int tl = g, ch = j; u32x4 raw[4][2];
#pragma unroll
          for (int h2 = 0; h2 < 4; ++h2) { const bf16_t* vp = kvraw + (size_t)(tok0 + tl) * 2048 + (hh + h2) * 256 + 128 + 16 * ch; raw[h2][0] = __builtin_nontemporal_load((const u32x4*)vp); raw[h2][1] = __builtin_nontemporal_load((const u32x4*)(vp + 8)); }
#pragma unroll
          for (int h2 = 0; h2 < 4; ++h2)
#pragma unroll
              for (int k = 0; k < 2; ++k) { float f[8]; unpack8(raw[h2][k], f); u32x4 w;
                  w.x = cvtpk(f[0] * rskv, f[1] * rskv); w.y = cvtpk(f[2] * rskv, f[3] * rskv); w.z = cvtpk(f[4] * rskv, f[5] * rskv); w.w = cvtpk(f[6] * rskv, f[7] * rskv);
                  *(LAS u32x4*)(VL + h2 * 8704 + tl * 136 + 16 * ch + 8 * k) = w; } }
        __syncthreads();
        { const int v = tid >> 2, tc = tid & 3;
#pragma unroll
          for (int h2 = 0; h2 < 4; ++h2) { bf16_t* vo = Vt + ((size_t)(b * 8 + hh + h2) * VD + v) * SEQ + s0;
#pragma unroll
              for (int cc = 0; cc < 2; ++cc) { const int tb = 8 * (2 * tc + cc); unsigned e[8];
#pragma unroll
                  for (int j = 0; j < 8; ++j) e[j] = VL[h2 * 8704 + (tb + j) * 136 + v];
                  u32x4 w; w.x = e[0] | (e[1] << 16); w.y = e[2] | (e[3] << 16); w.z = e[4] | (e[5] << 16); w.w = e[6] | (e[7] << 16);
                  *(u32x4*)(vo + tb) = w; } } }
        __syncthreads();
    }
}

constexpr int A_KB = 64 * 400, A_VB = 128 * 144, A_STAGE = A_KB + A_VB;
static_assert(2 * A_STAGE <= 131072, "attn lds");
__device__ __forceinline__ void attn_unit(const Params& p, LAS unsigned char* lds, int bh, int qb, float negB) {
    const int tid = opaque_tid(), lane = tid & 63, wave = __builtin_amdgcn_readfirstlane(tid >> 6), r = lane & 31, hi = lane >> 5;
    const int b = bh >> 3, h = bh & 7;
    const bf16_t* qn = (const bf16_t*)((unsigned char*)p.out + OUT_Q);
    const char* Kg = (const char*)(p.ws + WS_KN) + (size_t)bh * SEQ * QKD * 2; const char* Vg = (const char*)(p.ws + WS_VT) + (size_t)bh * VD * SEQ * 2;
    bf16_t* mix = (bf16_t*)(p.ws + WS_MIX);
    bf16x8 qf[12];
    {
        const int tq = b * SEQ + qb * 256 + wave * 32 + r;
        const bf16_t* qrow = qn + (size_t)tq * 1536 + h * 192 + hi * 8;
        const float rsq = ((const float*)(p.ws + WS_RS1))[tq];
        const float* cosT = (const float*)(p.ws + WS_ROPE) + (size_t)tq * 32; const float* sinT = cosT + (size_t)T * 32;
        const float* qw = p.qh_w; asm volatile("" : "+s"(qw));
        LAS unsigned char* qst = lds + wave * 16640;
#pragma unroll
        for (int i = 0; i < 12; ++i) { const int n = i * 64 + lane, row = n / 24, c = n % 24;
            *(LAS u32x4*)(qst + row * 400 + c * 16) = __builtin_nontemporal_load((const u32x4*)(qn + (size_t)(b * SEQ + qb * 256 + wave * 32 + row) * 1536 + h * 192 + 8 * c)); }
        float ss = 0.f;
#pragma unroll
        for (int ks = 0; ks < 12; ++ks) { qf[ks] = *(const LAS bf16x8*)(qst + r * 400 + ks * 32 + hi * 16); float f[8]; unpack8(__builtin_bit_cast(u32x4, qf[ks]), f);
#pragma unroll
            for (int e = 0; e < 8; ++e) ss += f[e] * f[e]; }
        ss += __shfl_xor(ss, 32); ss *= rsq * rsq;
        const float rr = rsq * rsqrtf(ss * (1.f / QKD) + EPS) * QSCALE;
#pragma unroll
        for (int ks = 0; ks < 12; ++ks) { u32x4 tq4 = __builtin_bit_cast(u32x4, qf[ks]); asm volatile("" : "+v"(tq4)); qf[ks] = __builtin_bit_cast(bf16x8, tq4); }
#pragma unroll
        for (int ks = 0; ks < 8; ++ks) { float f[8]; unpack8(__builtin_bit_cast(u32x4, qf[ks]), f); const f32x4 w0 = *(const f32x4*)(qw + 16 * ks + 8 * hi), w1 = *(const f32x4*)(qw + 16 * ks + 8 * hi + 4);
            u32x4 w; w.x = cvtpk(f[0] * rr * w0[0], f[1] * rr * w0[1]); w.y = cvtpk(f[2] * rr * w0[2], f[3] * rr * w0[3]); w.z = cvtpk(f[4] * rr * w1[0], f[5] * rr * w1[1]); w.w = cvtpk(f[6] * rr * w1[2], f[7] * rr * w1[3]);
            qf[ks] = __builtin_bit_cast(bf16x8, w); }
#pragma unroll
        for (int k2 = 0; k2 < 2; ++k2) {
            float fa[8], fb[8]; unpack8(__builtin_bit_cast(u32x4, qf[8 + k2]), fa); unpack8(__builtin_bit_cast(u32x4, qf[10 + k2]), fb);
            const int d1 = 128 + 16 * k2 + 8 * hi, fi = 16 * k2 + 8 * hi; float oa[8], ob[8];
#pragma unroll
            for (int e = 0; e < 8; ++e) { const float a = fa[e] * rr * qw[d1 + e], bb = fb[e] * rr * qw[d1 + 32 + e]; const float c = cosT[fi + e], sn = sinT[fi + e];
                oa[e] = a * c - bb * sn; ob[e] = a * sn + bb * c; }
            u32x4 w; w.x = cvtpk(oa[0], oa[1]); w.y = cvtpk(oa[2], oa[3]); w.z = cvtpk(oa[4], oa[5]); w.w = cvtpk(oa[6], oa[7]); qf[8 + k2] = __builtin_bit_cast(bf16x8, w);
            w.x = cvtpk(ob[0], ob[1]); w.y = cvtpk(ob[2], ob[3]); w.z = cvtpk(ob[4], ob[5]); w.w = cvtpk(ob[6], ob[7]); qf[10 + k2] = __builtin_bit_cast(bf16x8, w); }
    }
    __syncthreads();
    const int ntiles = 4 * qb + 4, mylast = 4 * qb + (wave >> 1);
    unsigned klo[3], vlo[2];
#pragma unroll
    for (int i = 0; i < 3; ++i) { const int q = tid + 512 * i, row = q / 24, cc = q % 24; klo[i] = row * 400 + cc * 16; }
#pragma unroll
    for (int i = 0; i < 2; ++i) { const int q = tid + 512 * i, v = q >> 3, cc = q & 7; vlo[i] = A_KB + v * 144 + cc * 16; }
    const __amdgpu_buffer_rsrc_t rk = __builtin_amdgcn_make_buffer_rsrc((void*)Kg, 0, 0x7fffffff, 0x00020000);
    const __amdgpu_buffer_rsrc_t rv = __builtin_amdgcn_make_buffer_rsrc((void*)Vg, 0, 0x7fffffff, 0x00020000);
    const unsigned kvo = (unsigned)tid * 16u, vvo = (unsigned)(tid >> 3) * (unsigned)(SEQ * 2) + (unsigned)(tid & 7) * 16u;
    int ktile = 0;
#define AT_LDK(i) __builtin_amdgcn_raw_buffer_load_b128(rk, kvo, ktile * (64 * 384) + (i) * 8192, 0)
#define AT_LDV(i) __builtin_amdgcn_raw_buffer_load_b128(rv, vvo, ktile * 128 + (i) * (64 * SEQ * 2), 0)
    u32x4 kreg[3], vreg[2];
#pragma unroll
    for (int i = 0; i < 3; ++i) kreg[i] = AT_LDK(i);
#pragma unroll
    for (int i = 0; i < 2; ++i) vreg[i] = AT_LDV(i);
#pragma unroll
    for (int i = 0; i < 3; ++i) *(LAS u32x4*)(lds + klo[i]) = kreg[i];
#pragma unroll
    for (int i = 0; i < 2; ++i) *(LAS u32x4*)(lds + vlo[i]) = vreg[i];
    ktile = 1;
#pragma unroll
    for (int i = 0; i < 3; ++i) kreg[i] = AT_LDK(i);
#pragma unroll
    for (int i = 0; i < 2; ++i) vreg[i] = AT_LDV(i);
    __syncthreads();
    f32x16 o[4];
#pragma unroll
    for (int vb = 0; vb < 4; ++vb)
#pragma unroll
        for (int i = 0; i < 16; ++i) o[vb][i] = 0.f;
    float lsum = 0.f;
    const unsigned ka = pi32(r) * 400 + hi * 16, va = A_KB + r * 144 + hi * 16;
    if (wave >= 4) __builtin_amdgcn_s_setprio(1);
    for (int t = 0; t < ntiles; ++t) {
        LAS unsigned char* nb = lds + ((t + 1) & 1) * A_STAGE;
#pragma unroll
        for (int i = 0; i < 3; ++i) *(LAS u32x4*)(nb + klo[i]) = kreg[i];
#pragma unroll
        for (int i = 0; i < 2; ++i) *(LAS u32x4*)(nb + vlo[i]) = vreg[i];
        ktile += (t + 2 < ntiles) ? 1 : 0;
#pragma unroll
        for (int i = 0; i < 3; ++i) kreg[i] = AT_LDK(i);
#pragma unroll
        for (int i = 0; i < 2; ++i) vreg[i] = AT_LDV(i);
        if (t <= mylast) {
            LAS unsigned char* buf = lds + (t & 1) * A_STAGE;
            f32x16 s0, s1; float nbv = negB; asm volatile("" : "+v"(nbv));
#pragma unroll
            for (int i = 0; i < 16; ++i) s0[i] = nbv;
#define AT_RD(j) (*(const LAS bf16x8*)(buf + ((j) < 12 ? ka + (j) * 32 : (j) < 24 ? ka + 32 * 400 + ((j) - 12) * 32 : va + (((j) - 24) & 3) * (32 * 144) + (((j) - 24) >> 2) * 32)))
            bf16x8 fr[8]; bf16x8 pb[4];
#pragma unroll
            for (int j = 0; j < 6; ++j) fr[j] = AT_RD(j);
            __builtin_amdgcn_sched_barrier(0);
#pragma unroll
            for (int j = 0; j < 40; ++j) {
                if (j + 6 < 40) fr[(j + 6) & 7] = AT_RD(j + 6);
                if (j < 12) s0 = MFMA32(fr[j & 7], qf[j], s0);
                else if (j < 24) s1 = MFMA32(fr[j & 7], qf[j - 12], s1);
                else o[(j - 24) & 3] = MFMA32(fr[j & 7], pb[(j - 24) >> 2], o[(j - 24) & 3]);
                if (j >= 13 && j < 21) { const int e = 2 * (j - 13); s0[e] = __builtin_amdgcn_exp2f(s0[e]); s0[e + 1] = __builtin_amdgcn_exp2f(s0[e + 1]); lsum += s0[e] + s0[e + 1]; }
                if (j == 11) {
#pragma unroll
                    for (int i = 0; i < 16; ++i) s1[i] = nbv; }
                if (j == 21) pb[0] = pack8(s0, 0);
                if (j == 22) pb[1] = pack8(s0, 1);
                if (j >= 25 && j < 27) { const int e = 3 * (j - 25);
                    s1[e] = __builtin_amdgcn_exp2f(s1[e]); s1[e + 1] = __builtin_amdgcn_exp2f(s1[e + 1]); s1[e + 2] = __builtin_amdgcn_exp2f(s1[e + 2]); lsum += s1[e] + s1[e + 1] + s1[e + 2]; }
                if (j >= 27 && j < 32) { const int e = 6 + 2 * (j - 27); s1[e] = __builtin_amdgcn_exp2f(s1[e]); s1[e + 1] = __builtin_amdgcn_exp2f(s1[e + 1]); lsum += s1[e] + s1[e + 1]; }
                if (j == 31) { pb[2] = pack8(s1, 0); pb[3] = pack8(s1, 1); }
                __builtin_amdgcn_sched_barrier(0);
            }
#undef AT_RD
        }
        __syncthreads();
    }
#undef AT_LDK
#undef AT_LDV
    if (wave >= 4) __builtin_amdgcn_s_setprio(0);
    lsum += __shfl_xor(lsum, 32);
    const float inv = __builtin_amdgcn_rcpf(lsum);
    {
        LAS unsigned char* ost = lds + wave * 16640;
#pragma unroll
        for (int vb = 0; vb < 4; ++vb)
#pragma unroll
            for (int g = 0; g < 4; ++g) { u32x2 w; w.x = cvtpk(o[vb][4 * g] * inv, o[vb][4 * g + 1] * inv); w.y = cvtpk(o[vb][4 * g + 2] * inv, o[vb][4 * g + 3] * inv);
                *(LAS u32x2*)(ost + r * 264 + (32 * vb + 8 * g + 4 * hi) * 2) = w; }
        bf16_t* ob = mix + (size_t)(b * SEQ + qb * 256 + wave * 32) * DM + 1024 + h * 128;
#pragma unroll
        for (int i = 0; i < 8; ++i) { const int row = 4 * i + (lane >> 4), c16 = lane & 15;
            const u32x2 lo = *(const LAS u32x2*)(ost + row * 264 + c16 * 16), hi2 = *(const LAS u32x2*)(ost + row * 264 + c16 * 16 + 8);
            *(u32x4*)(ob + (size_t)row * DM + c16 * 8) = (u32x4){lo.x, lo.y, hi2.x, hi2.y}; }
    }
    __syncthreads();
}

#define XB_XCNT(j)  (256  + 64 * (j))
#define XB_XSUB(j)  (1280 + 64 * (j))
#define XB_XGEN(j)  (2304 + 64 * (j))
#define XB_TOP      3328
#define XB_TOPGEN   3392
constexpr int XB_LDS = 147456 - 64;
__device__ __forceinline__ unsigned xb_ld(unsigned* p)              { return __hip_atomic_load(p, __ATOMIC_RELAXED, __HIP_MEMORY_SCOPE_AGENT); }
__device__ __forceinline__ unsigned xb_add(unsigned* p, unsigned v) { return __hip_atomic_fetch_add(p, v, __ATOMIC_RELAXED, __HIP_MEMORY_SCOPE_AGENT); }
__device__ __forceinline__ unsigned xb_xcc_id() { return (unsigned)__builtin_amdgcn_s_getreg((3 << 11) | 20) & 0xFu; }
#define XB_SPIN(cond) do { unsigned _sp = 0; while (cond) { __builtin_amdgcn_s_sleep(1); if (++_sp > (1u << 24)) break; } } while (0)
__device__ __forceinline__ void xcd_census_post(unsigned* bar, LAS unsigned char* lds) {
    if (threadIdx.x == 0) { const unsigned x = xb_xcc_id(); ((volatile LAS unsigned*)(lds + XB_LDS))[2] = x; (void)xb_add(&bar[XB_XCNT(x)], 1u); }
}
__device__ __forceinline__ void xcd_census_read(unsigned* bar, LAS unsigned char* lds) {
    if (threadIdx.x == 0) { volatile LAS unsigned* st = (volatile LAS unsigned*)(lds + XB_LDS); const unsigned x = st[2]; unsigned cnt = 0u, mine = 1u;
        for (unsigned j = 0; j < 16; ++j) { const unsigned c = xb_ld(&bar[XB_XCNT(j)]); cnt += (c > 0u) ? 1u : 0u; if (j == x) mine = c; }
        st[0] = mine > 0u ? mine : 1u; st[1] = cnt > 0u ? cnt : 1u; }
    __syncthreads();
}
__device__ __forceinline__ void xcd_barrier(unsigned* bar, LAS unsigned char* lds) {
    asm volatile("s_waitcnt vmcnt(0)" ::: "memory");
    __syncthreads();
    if (threadIdx.x == 0) {
        volatile LAS unsigned* st = (volatile LAS unsigned*)(lds + XB_LDS);
        __builtin_amdgcn_s_waitcnt(0);
        const unsigned nloc = st[0], nx = st[1], x = st[2];
        const unsigned old = xb_add(&bar[XB_XSUB(x)], 1u);
        const unsigned gen = old / nloc;
        if (old + 1u == (gen + 1u) * nloc) {
            __builtin_amdgcn_fence(__ATOMIC_RELEASE, "agent");
            asm volatile("s_waitcnt vmcnt(0)" ::: "memory");
            const unsigned og = xb_add(&bar[XB_TOP], 1u);
            const unsigned tg = og / nx;
            if (og + 1u == (tg + 1u) * nx) xb_add(&bar[XB_TOPGEN], 1u);
            else XB_SPIN(xb_ld(&bar[XB_TOPGEN]) == tg);
            __builtin_amdgcn_fence(__ATOMIC_ACQUIRE, "agent");
            xb_add(&bar[XB_XGEN(x)], 1u);
            asm volatile("s_waitcnt vmcnt(0)" ::: "memory");
        } else {
            XB_SPIN(xb_ld(&bar[XB_XGEN(x)]) == gen);
            __builtin_amdgcn_fence(__ATOMIC_ACQUIRE, "agent");
            asm volatile("s_waitcnt vmcnt(0)" ::: "memory");
        }
    }
    __syncthreads();
}

__global__ void __launch_bounds__(512, 2) fwd_mega(Params p) {
    extern __shared__ __attribute__((aligned(16))) unsigned char lds_raw[];
    LAS unsigned char* lds = (LAS unsigned char*)lds_raw;
    cg::grid_group grid = cg::this_grid();
    const int G = gridDim.x, bx = blockIdx.x;
    unsigned char* ws = p.ws;

    unsigned* bar = (unsigned*)(ws + WS_BAR);
    xcd_census_post(bar, lds);
    p0_prep(p, lds);
    grid.sync();
    xcd_census_read(bar, lds);

    { pg8::Gemm g{(const bf16_t*)(ws + WS_XB), (const bf16_t*)(ws + WS_WIN), T, 5120, DM, DM}; pg8::StaticOrder S; S.init(T, 5120, G, bx);
      pg8::EpiBf16S E{(bf16_t*)(ws + WS_PROJ), DIN, (const float*)(ws + WS_RS1), DIN};
      pg8::gemm_phase<pg8::EpiBf16S>(lds, g, S, E); }
    xcd_barrier(bar, lds);

    { const bool bal = (G == 256);
      const int nmine = !bal ? (2048 - bx + G - 1) / G : ((bx < 64 || bx >= 192) ? 9 : 7);
#define P2_PASS_A() do { for (int k = 0; k < nmine; ++k) { const int u = !bal ? bx + G * k : (k < 8 ? bx + 256 * k : (bx < 64 ? bx + 64 : bx - 64) + 1792); hgrn_pass_a(p, lds, u); } } while (0)
      if (bx & 1) P2_PASS_A();
      const int gs = bal ? 192 : G, cs = bal ? bx - 64 : bx;
      if (!bal || bx < 64) { pg8::Gemm g{(const bf16_t*)(ws + WS_XB), (const bf16_t*)(ws + WS_WIN) + (size_t)5120 * DM, T, 256, DM, DM}; pg8::StaticOrder S; S.init(T, 256, bal ? 64 : G, bx);
          pg8::EpiBf16S E{(bf16_t*)(ws + WS_PROJ) + 5120, DIN, (const float*)(ws + WS_RS1), DIN - 5120};
          pg8::gemm_phase<pg8::EpiBf16S>(lds, g, S, E); }
      if (!bal || bx >= 64) {
          { pg8::Gemm g{(const bf16_t*)(ws + WS_PROJ) + 4096, (const bf16_t*)(ws + WS_WUQ), T, MH * QKD, QL, DIN}; pg8::StaticOrder S; S.init(T, MH * QKD, gs, cs);
            pg8::EpiBf16S E{(bf16_t*)((unsigned char*)p.out + OUT_Q), MH * QKD, nullptr, MH * QKD};
            pg8::gemm_phase<pg8::EpiBf16S>(lds, g, S, E); }
          { pg8::Gemm g{(const bf16_t*)(ws + WS_PROJ) + 4608, (const bf16_t*)(ws + WS_WUKV), T, 2048, KVL, DIN}; pg8::StaticOrder S; S.init(T, 2048, gs, cs);
            pg8::EpiBf16S E{(bf16_t*)(ws + WS_MIX), 2048, nullptr, 2048};
            pg8::gemm_phase<pg8::EpiBf16S>(lds, g, S, E); } }
      if (!(bx & 1)) P2_PASS_A();
#undef P2_PASS_A
    }
    xcd_barrier(bar, lds);

    for (int tile = bx; tile < T / 64; tile += G) p3_tile(p, lds, tile);
    hgrn_scan(p);
    xcd_barrier(bar, lds);

    { float mq = 0.f, mk = 0.f; const int lane = opaque_tid() & 63;
      for (int i = lane; i < QKD; i += 64) { mq = fmaxf(mq, fabsf(p.qh_w[i])); mk = fmaxf(mk, fabsf(p.kh_w[i])); }
      mq = wave_max(mq); mk = wave_max(mk);
      const float negB = -(13.856406460551018f * LOG2E) * mq * mk;
      const int wvc = __builtin_amdgcn_readfirstlane(opaque_tid() >> 6); bool cdone = false;
      for (int it = bx; it < 256; it += G) { const int bh = it >> 4, pq = it & 15; const int qa = (bx & 1) ? 31 - pq : pq, qb2 = (bx & 1) ? pq : 31 - pq;
          attn_unit(p, lds, bh, qa, negB);
          if (!cdone) { for (int u = bx * 8 + wvc; u < 2048; u += G * 8) hgrn_pass_c(p, lds + wvc * 16640, u);
              convert_range(p, lds, IT_EARLY, IT_ALL, bx * 8 + wvc, G * 8, wvc, opaque_tid() & 63);
              __syncthreads(); cdone = true; }
          attn_unit(p, lds, bh, qb2, negB); }
      if (!cdone) { for (int u = bx * 8 + wvc; u < 2048; u += G * 8) hgrn_pass_c(p, lds + wvc * 16640, u);
          convert_range(p, lds, IT_EARLY, IT_ALL, bx * 8 + wvc, G * 8, wvc, opaque_tid() & 63); } }
    xcd_barrier(bar, lds);

    { pg8::Gemm g{(const bf16_t*)(ws + WS_MIX), (const bf16_t*)(ws + WS_WOUT), T, DM, DM, DM}; pg8::StaticOrder S; S.init(T, DM, G, bx);
      pg8::EpiResid1 E{(bf16_t*)(ws + WS_XB), (float*)(ws + WS_SS2)};
      pg8::gemm_phase<pg8::EpiResid1>(lds, g, S, E); }
    xcd_barrier(bar, lds);

    { pg8::Gemm g{(const bf16_t*)(ws + WS_XB), (const bf16_t*)(ws + WS_WGU), T, 2 * DFF, DM, DM}; pg8::StaticOrder S; S.init(T, 2 * DFF, G, bx);
      pg8::EpiSwiGLU E{(bf16_t*)(ws + WS_PROJ), (const float*)(ws + WS_SS2)};
      pg8::gemm_phase<pg8::EpiSwiGLU>(lds, g, S, E); }
    xcd_barrier(bar, lds);

    { pg8::Gemm g{(const bf16_t*)(ws + WS_PROJ), (const bf16_t*)(ws + WS_WDN), T, DM, DFF, DFF}; pg8::StaticOrder S; S.init(T, DM, G, bx);
      pg8::EpiAccum E{p.out, (const bf16_t*)(ws + WS_XB)};
      pg8::gemm_phase<pg8::EpiAccum>(lds, g, S, E); }
}

extern "C" void kernel_launch(void* const* d_in, const int* in_sizes, int n_in, void* d_out, int out_size, void* d_ws, size_t ws_size, hipStream_t stream) {
    static int grid = 0;
    if (grid == 0) {
        int dev = 0, cus = 0, per_cu = 0;
        hipGetDevice(&dev);
        hipDeviceGetAttribute(&cus, hipDeviceAttributeMultiprocessorCount, dev);
        hipFuncSetAttribute((const void*)fwd_mega, hipFuncAttributeMaxDynamicSharedMemorySize, LDS_BYTES);
        hipOccupancyMaxActiveBlocksPerMultiprocessor(&per_cu, (const void*)fwd_mega, 512, LDS_BYTES);
        if (per_cu < 1) per_cu = 1;
        grid = cus * per_cu;
        if (ws_size < WS_END) { fprintf(stderr, "kernel_launch: workspace too small (%zu < %zu)\n", ws_size, (size_t)WS_END); grid = -1; }
    }
    if (grid < 0) return;
    Params p{};
    p.x = (const float*)d_in[0]; p.pos = (const int*)d_in[1]; p.attn_norm_w = (const float*)d_in[2]; p.w_in = (const float*)d_in[3];
    p.hgrn_lb = (const float*)d_in[4]; p.hgrn_norm_w = (const float*)d_in[5]; p.q_norm_w = (const float*)d_in[6]; p.w_uq = (const float*)d_in[7];
    p.kv_norm_w = (const float*)d_in[8]; p.w_ukv = (const float*)d_in[9]; p.qh_w = (const float*)d_in[10]; p.kh_w = (const float*)d_in[11];
    p.w_out = (const float*)d_in[12]; p.ffn_norm_w = (const float*)d_in[13]; p.w_gu = (const float*)d_in[14]; p.w_dn = (const float*)d_in[15];
    p.out = (float*)d_out; p.ws = (unsigned char*)d_ws;
    hipMemsetAsync((unsigned char*)d_ws + WS_BAR, 0, 16384, stream);
    void* args[] = {&p};
    hipError_t e = hipLaunchCooperativeKernel((const void*)fwd_mega, dim3(grid), dim3(512), args, LDS_BYTES, stream);
    if (e != hipSuccess) fprintf(stderr, "cooperative launch failed: %s (grid %d)\n", hipGetErrorString(e), grid);
}
```
